# Optimizing an MI355X kernel written in HIP

```python
import jax
import jax.numpy as jnp
from jax import lax
import numpy as np

D_MODEL = 1024
BATCH = 2
SEQ = 16384
DEPTH = 2

GRID_W = 64
CTX_LEN = 256
EPS = 1e-6

N_Q_HEADS = 8
N_KV_HEADS = 2
GQA_GROUP = N_Q_HEADS // N_KV_HEADS
HEAD_DIM = 64
WINDOW = 128
ATTN_BLOCK = 128
ROPE_BASE = 10000.0
ATT_Q_W = N_Q_HEADS * HEAD_DIM
ATT_KV_W = N_KV_HEADS * HEAD_DIM
SGU_HEADS = 4
SGU_HEAD_DIM = 64
SGU_W = SGU_HEADS * SGU_HEAD_DIM
SGU_CHUNK = 128
POOL_WINDOWS = (2, 4, 8, 16)
POOL_GROUPS = 4
POOL_GROUP_DIM = 64
POOL_CH = POOL_GROUPS * POOL_GROUP_DIM
CONV_CH = 256
CONV_WIDTH = 3

MIX_WIDTH = ATT_Q_W + SGU_W + POOL_CH + CONV_CH
IN_COLS = ATT_Q_W + 2 * ATT_KV_W + 2 * SGU_W + POOL_CH + 3 * CONV_CH
_Q_END = ATT_Q_W
_K_END = _Q_END + ATT_KV_W
_V_END = _K_END + ATT_KV_W
_SU_END = _V_END + SGU_W
_SV_END = _SU_END + SGU_W
_POOL_END = _SV_END + POOL_CH
_CB_END = _POOL_END + CONV_CH
_CC_END = _CB_END + CONV_CH
SPLIT_POINTS = (_Q_END, _K_END, _V_END, _SU_END, _SV_END, _POOL_END, _CB_END, _CC_END)

N_EXPERTS = 32
TOP_K = 4
D_FF_EXPERT = 1024
SWIGLU_LIMIT = 7.0
SWIGLU_ALPHA = 1.702
MOE_BLOCK = 128

kernel_name = 'hybrid_parallel_group_dit_moe'


def rms_norm(x, g):
    xf = x.astype(jnp.float32)
    y = xf * lax.rsqrt(jnp.mean(xf * xf, axis=-1, keepdims=True) + EPS)
    return (y * g.astype(jnp.float32)).astype(x.dtype)


def layer_norm(x, g, b):
    xf = x.astype(jnp.float32)
    mu = jnp.mean(xf, axis=-1, keepdims=True)
    var = jnp.mean(jnp.square(xf - mu), axis=-1, keepdims=True)
    y = (xf - mu) * lax.rsqrt(var + EPS) * g.astype(jnp.float32) + b.astype(jnp.float32)
    return y.astype(x.dtype)


def modulate(h, shift, scale):
    return h * (1 + scale) + shift


def heads(t, n):
    return t.reshape(t.shape[:-1] + (n, t.shape[-1] // n))


def axial_rope_tables(n_tokens):
    rows = n_tokens // GRID_W
    row = jnp.repeat(jnp.arange(rows), GRID_W).astype(jnp.float32)
    col = jnp.tile(jnp.arange(GRID_W), rows).astype(jnp.float32)
    n_freq = HEAD_DIM // 4
    inv = ROPE_BASE ** (-jnp.arange(n_freq, dtype=jnp.float32) / n_freq)
    ang = jnp.concatenate([row[:, None] * inv, col[:, None] * inv], axis=-1)
    return jnp.cos(ang), jnp.sin(ang)


def apply_rope(x, cos, sin):
    xf = x.astype(jnp.float32)
    half = HEAD_DIM // 2
    x1, x2 = xf[..., :half], xf[..., half:]
    cs, sn = cos[None, :, None, :], sin[None, :, None, :]
    return jnp.concatenate([x1 * cs - x2 * sn, x1 * sn + x2 * cs], axis=-1).astype(x.dtype)


def window_attention(q, k, v, kc, vc, sink):
    B, S = q.shape[0], q.shape[1]
    L = kc.shape[1]
    nb = S // ATTN_BLOCK
    scale = HEAD_DIM ** -0.5
    qb = q.reshape(B, nb, ATTN_BLOCK, N_KV_HEADS, GQA_GROUP, HEAD_DIM)

    def band(t):
        tp = jnp.pad(t, ((0, 0), (ATTN_BLOCK, ATTN_BLOCK), (0, 0), (0, 0)))
        blocks = tp.reshape(B, nb + 2, ATTN_BLOCK, N_KV_HEADS, HEAD_DIM)
        return jnp.concatenate([blocks[:, :-2], blocks[:, 1:-1], blocks[:, 2:]], axis=2)

    kb, vb = band(k), band(v)
    blk = jnp.arange(nb)[:, None, None]
    qpos = blk * ATTN_BLOCK + jnp.arange(ATTN_BLOCK)[None, :, None]
    kpos = (blk - 1) * ATTN_BLOCK + jnp.arange(3 * ATTN_BLOCK)[None, None, :]
    valid = (jnp.abs(qpos - kpos) <= WINDOW) & (kpos >= 0) & (kpos < S)
    s_band = jnp.einsum('bnqkgd,bnskd->bnkgqs', qb, kb).astype(jnp.float32) * scale
    s_band = jnp.where(valid[None, :, None, None], s_band, -jnp.inf)
    s_ctx = jnp.einsum('bnqkgd,blkd->bnkgql', qb, kc).astype(jnp.float32) * scale
    s_sink = jnp.broadcast_to(sink.astype(jnp.float32).reshape(N_KV_HEADS, GQA_GROUP)[None, None, :, :, None, None],
                              s_band.shape[:-1] + (1,))
    probs = jax.nn.softmax(jnp.concatenate([s_band, s_ctx, s_sink], axis=-1), axis=-1)
    nband = 3 * ATTN_BLOCK
    p_band = probs[..., :nband].astype(v.dtype)
    p_ctx = probs[..., nband:nband + L].astype(vc.dtype)
    o = (jnp.einsum('bnkgqs,bnskd->bnqkgd', p_band, vb)
         + jnp.einsum('bnkgql,blkd->bnqkgd', p_ctx, vc))
    return o.reshape(B, S, ATT_Q_W)


def context_attention(qc, kc, vc, sink):
    B, L = qc.shape[0], qc.shape[1]
    scale = HEAD_DIM ** -0.5
    qg = qc.reshape(B, L, N_KV_HEADS, GQA_GROUP, HEAD_DIM)
    s = jnp.einsum('bqkgd,blkd->bkgql', qg, kc).astype(jnp.float32) * scale
    s_sink = jnp.broadcast_to(sink.astype(jnp.float32).reshape(N_KV_HEADS, GQA_GROUP)[None, :, :, None, None],
                              s.shape[:-1] + (1,))
    probs = jax.nn.softmax(jnp.concatenate([s, s_sink], axis=-1), axis=-1)[..., :L]
    o = jnp.einsum('bkgql,blkd->bqkgd', probs.astype(vc.dtype), vc)
    return o.reshape(B, L, ATT_Q_W)


def chunk_sgu(u, v, ws, bs, ln_g, ln_b):
    B, N, _ = v.shape
    nc = N // SGU_CHUNK
    vn = layer_norm(v, ln_g, ln_b).reshape(B, nc, SGU_CHUNK, SGU_HEADS, SGU_HEAD_DIM)
    s = jnp.einsum('hpr,bcrhd->bcphd', ws, vn) + bs.T[None, None, :, :, None]
    return u * s.reshape(B, N, SGU_W)


def multiscale_pool(xp, pool_w, pool_scale):
    B, N, _ = xp.shape
    xf = xp.astype(jnp.float32)
    cs = jnp.concatenate([jnp.zeros((B, 1, POOL_CH), jnp.float32), jnp.cumsum(xf, axis=1)], axis=1)
    t = jnp.arange(N)
    pooled = []
    for gi, w in enumerate(POOL_WINDOWS):
        lo = jnp.clip(t - w // 2, 0, N)
        hi = jnp.clip(t + w - w // 2, 0, N)
        csg = cs[..., gi * POOL_GROUP_DIM:(gi + 1) * POOL_GROUP_DIM]
        cnt = (hi - lo).astype(jnp.float32)
        pooled.append((csg[:, hi] - csg[:, lo]) / cnt[None, :, None])
    d = (jnp.concatenate(pooled, axis=-1) - xf).astype(xp.dtype)
    d = d.reshape(B, N, POOL_GROUPS, POOL_GROUP_DIM)
    y = jnp.einsum('bngc,gcd->bngd', d, pool_w).reshape(B, N, POOL_CH)
    return y * pool_scale


def short_conv(cb, cc, cx, conv_w):
    y = cc * cx
    rhs = conv_w[:, None, :].astype(y.dtype)
    z = lax.conv_general_dilated(y, rhs, window_strides=(1,),
                                 padding=((CONV_WIDTH // 2, CONV_WIDTH // 2),),
                                 dimension_numbers=('NWC', 'WIO', 'NWC'),
                                 feature_group_count=CONV_CH)
    return cb * z


def gated_mixers(su, sv, xp, cb, cc, cx, sgu_ws, sgu_b, sgu_ln_g, sgu_ln_b, pool_w, pool_scale, conv_w):
    y_b = chunk_sgu(jax.nn.gelu(su, approximate=False), jax.nn.gelu(sv, approximate=False),
                    sgu_ws, sgu_b, sgu_ln_g, sgu_ln_b)
    y_c = multiscale_pool(xp, pool_w, pool_scale)
    y_d = short_conv(cb, cc, cx, conv_w)
    return y_b, y_c, y_d


def moe(h, router_w, router_b, w1, b1, w2, b2):
    T, D = h.shape
    logits = (h @ router_w).astype(jnp.float32) + router_b.astype(jnp.float32)
    top_v, top_i = lax.top_k(logits, TOP_K)
    gates = jax.nn.softmax(top_v, axis=-1)
    flat_e = top_i.reshape(-1)
    flat_t = jnp.broadcast_to(jnp.arange(T)[:, None], (T, TOP_K)).reshape(-1)
    flat_g = gates.reshape(-1)
    order = jnp.argsort(flat_e)
    se, st, sg = flat_e[order], flat_t[order], flat_g[order]
    counts = jnp.bincount(flat_e, length=N_EXPERTS)
    starts = jnp.cumsum(counts) - counts
    padded = (counts + MOE_BLOCK - 1) // MOE_BLOCK * MOE_BLOCK
    pends = jnp.cumsum(padded)
    pstarts = pends - padded
    dest = pstarts[se] + (jnp.arange(T * TOP_K) - starts[se])
    n_blocks = -(-(T * TOP_K) // MOE_BLOCK) + N_EXPERTS
    n_slots = n_blocks * MOE_BLOCK
    slot_tok = jnp.full((n_slots,), T, jnp.int32).at[dest].set(st.astype(jnp.int32))
    slot_gate = jnp.zeros((n_slots,), h.dtype).at[dest].set(sg.astype(h.dtype))
    block_e = jnp.minimum(jnp.searchsorted(pends, jnp.arange(n_blocks) * MOE_BLOCK, side='right'), N_EXPERTS - 1)
    h_pad = jnp.concatenate([h, jnp.zeros((1, D), h.dtype)], axis=0)
    xs = h_pad[slot_tok].reshape(n_blocks, MOE_BLOCK, D)

    def expert_block(args):
        xb, e = args
        z = xb @ w1[e] + b1[e]
        g = jnp.minimum(z[:, ::2], SWIGLU_LIMIT)
        lin = jnp.clip(z[:, 1::2], -SWIGLU_LIMIT, SWIGLU_LIMIT)
        a = g * jax.nn.sigmoid(SWIGLU_ALPHA * g) * (lin + 1)
        return a @ w2[e] + b2[e]

    ys = lax.map(expert_block, (xs, block_e)).reshape(n_slots, D)
    out = jnp.zeros((T + 1, D), h.dtype).at[slot_tok].add(ys * slot_gate[:, None])
    return out[:T]


def setup_inputs(seed: int = 0) -> dict:
    key = jax.random.key(seed)
    ks = jax.random.split(key, 26)
    f32 = jnp.float32
    D = D_MODEL
    L = DEPTH

    def nrm(k, shape, s):
        return jax.random.normal(k, shape, f32) * s

    return {
        'x': nrm(ks[0], (BATCH, SEQ, D), 1.0),
        'c': nrm(ks[1], (BATCH, D), 1.0),
        'ctx': nrm(ks[2], (BATCH, CTX_LEN, D), 1.0),
        'c_ctx': nrm(ks[3], (D,), 1.0),
        'norm1_g': 1.0 + nrm(ks[4], (L, D), 0.02),
        'norm2_g': 1.0 + nrm(ks[5], (L, D), 0.02),
        'ada_w': nrm(ks[6], (L, D, 6 * D), 0.5 * D ** -0.5),
        'ada_b': nrm(ks[7], (L, 6 * D), 0.02),
        'w_in': nrm(ks[8], (L, D, IN_COLS), D ** -0.5),
        'attn_sink': nrm(ks[9], (L, N_Q_HEADS), 0.5),
        'sgu_ws': nrm(ks[10], (L, SGU_HEADS, SGU_CHUNK, SGU_CHUNK), 0.5 * SGU_CHUNK ** -0.5),
        'sgu_b': 1.0 + nrm(ks[11], (L, SGU_HEADS, SGU_CHUNK), 0.02),
        'sgu_ln_g': 1.0 + nrm(ks[12], (L, SGU_W), 0.02),
        'sgu_ln_b': nrm(ks[13], (L, SGU_W), 0.02),
        'pool_w': nrm(ks[14], (L, POOL_GROUPS, POOL_GROUP_DIM, POOL_GROUP_DIM), POOL_GROUP_DIM ** -0.5),
        'pool_scale': 1.0 + nrm(ks[15], (L, POOL_CH), 0.02),
        'conv_w': nrm(ks[16], (L, CONV_WIDTH, CONV_CH), CONV_WIDTH ** -0.5),
        'w_out': nrm(ks[17], (L, MIX_WIDTH, D), MIX_WIDTH ** -0.5),
        'router_w': nrm(ks[18], (L, D, N_EXPERTS), D ** -0.5),
        'router_b': nrm(ks[19], (L, N_EXPERTS), 0.01),
        'exp_w1': nrm(ks[20], (L, N_EXPERTS, D, 2 * D_FF_EXPERT), D ** -0.5),
        'exp_b1': nrm(ks[21], (L, N_EXPERTS, 2 * D_FF_EXPERT), 0.02),
        'exp_w2': nrm(ks[22], (L, N_EXPERTS, D_FF_EXPERT, D), D_FF_EXPERT ** -0.5),
        'exp_b2': nrm(ks[23], (L, N_EXPERTS, D), 0.02),
        'final_g': 1.0 + nrm(ks[24], (D,), 0.02),
    }


def reference(x, c, ctx, c_ctx, norm1_g, norm2_g, ada_w, ada_b, w_in, attn_sink, sgu_ws, sgu_b,
              sgu_ln_g, sgu_ln_b, pool_w, pool_scale, conv_w, w_out, router_w, router_b,
              exp_w1, exp_b1, exp_w2, exp_b2, final_g):
    B, S, D = x.shape
    L = ctx.shape[1]
    cos, sin = axial_rope_tables(S)
    xl, xc = x, ctx
    silu_c = jax.nn.silu(c)
    silu_cc = jax.nn.silu(c_ctx)
    for l in range(DEPTH):
        last = l == DEPTH - 1
        mod_l = (silu_c @ ada_w[l] + ada_b[l])[:, None, :]
        mod_c = (silu_cc @ ada_w[l] + ada_b[l])[None, None, :]
        sh1l, sc1l, g1l, sh2l, sc2l, g2l = jnp.split(mod_l, 6, axis=-1)
        sh1c, sc1c, g1c, sh2c, sc2c, g2c = jnp.split(mod_c, 6, axis=-1)
        mix_params = (sgu_ws[l], sgu_b[l], sgu_ln_g[l], sgu_ln_b[l], pool_w[l], pool_scale[l], conv_w[l])

        hc = modulate(rms_norm(xc, norm1_g[l]), sh1c, sc1c)
        if last:
            kv_c = hc @ w_in[l][:, _Q_END:_V_END]
            kc = heads(kv_c[..., :ATT_KV_W], N_KV_HEADS)
            vc = heads(kv_c[..., ATT_KV_W:], N_KV_HEADS)
        else:
            pc = jnp.split(hc @ w_in[l], SPLIT_POINTS, axis=-1)
            kc = heads(pc[1], N_KV_HEADS)
            vc = heads(pc[2], N_KV_HEADS)
            attn_c = context_attention(heads(pc[0], N_Q_HEADS), kc, vc, attn_sink[l])
            yb_c, yc_c, yd_c = gated_mixers(*pc[3:], *mix_params)
            mix_c = jnp.concatenate([attn_c, yb_c, yc_c, yd_c], axis=-1) @ w_out[l]
            xc_mid = xc + g1c * mix_c

        hl = modulate(rms_norm(xl, norm1_g[l]), sh1l, sc1l)
        pl = jnp.split(hl @ w_in[l], SPLIT_POINTS, axis=-1)
        ql = apply_rope(heads(pl[0], N_Q_HEADS), cos, sin)
        kl = apply_rope(heads(pl[1], N_KV_HEADS), cos, sin)
        vl = heads(pl[2], N_KV_HEADS)
        attn_l = window_attention(ql, kl, vl, kc, vc, attn_sink[l])
        yb_l, yc_l, yd_l = gated_mixers(*pl[3:], *mix_params)
        mix_l = jnp.concatenate([attn_l, yb_l, yc_l, yd_l], axis=-1) @ w_out[l]
        xl = xl + g1l * mix_l

        hl2 = modulate(rms_norm(xl, norm2_g[l]), sh2l, sc2l).reshape(B * S, D)
        moe_args = (router_w[l], router_b[l], exp_w1[l], exp_b1[l], exp_w2[l], exp_b2[l])
        if last:
            xl = xl + g2l * moe(hl2, *moe_args).reshape(B, S, D)
        else:
            hc2 = modulate(rms_norm(xc_mid, norm2_g[l]), sh2c, sc2c).reshape(B * L, D)
            y = moe(jnp.concatenate([hl2, hc2], axis=0), *moe_args)
            xl = xl + g2l * y[:B * S].reshape(B, S, D)
            xc = xc_mid + g2c * y[B * S:].reshape(B, L, D)
    return rms_norm(xl, final_g)
```

```cpp
#include <hip/hip_runtime.h>
#include <cstdio>
#include <cstdint>

#ifndef MK_N_LAUNCHES
#define MK_N_LAUNCHES 16
#endif

constexpr int D = 1024, NB = 2, S = 16384, LC = 256, DEPTH = 2;
constexpr int TL = NB * S, TC = NB * LC, MT = TL + TC;
constexpr int INC = 2304, MIXW = 1280, NE = 32, FF = 1024, FF2 = 2048;
constexpr int CAP = MT;
constexpr int MAXTILES = (MT * 4) / 256 + NE;
constexpr int NPHASES = 2 + 7 * DEPTH;
constexpr float EPS = 1e-6f;
constexpr float LOG2E = 1.4426950408889634f;
constexpr float QSCALE = 0.125f * LOG2E;
constexpr int PC_Q = 0, PC_K = 512, PC_V = 640, PC_SU = 768, PC_SV = 1024, PC_XP = 1280, PC_CB = 1536, PC_CC = 1792, PC_CX = 2048;

constexpr size_t MiB = 1u << 20;
constexpr size_t WS_CTL = 0, CTL_ZERO_BYTES = 1 * MiB;
constexpr size_t WS_MOD = 1 * MiB;
constexpr size_t WS_ROPE = 1 * MiB + 512 * 1024;
constexpr size_t WS_SLOT_TOK = 2 * MiB, WS_SLOT_ASG = 7 * MiB, WS_SLOT_GATE = 12 * MiB;
constexpr size_t WS_WIN = 17 * MiB;
constexpr size_t WS_WOUT = 26 * MiB;
constexpr size_t WS_W1 = 32 * MiB;
constexpr size_t WS_W2 = 288 * MiB;
constexpr size_t WS_XL = 416 * MiB;
constexpr size_t WS_H = 547 * MiB;
constexpr size_t WS_P = 613 * MiB;
constexpr size_t WS_MIX = 760 * MiB;
constexpr size_t WS_ACT = 842 * MiB;
constexpr size_t WS_Y = 1119 * MiB;
constexpr size_t WS_END = 1380 * MiB;
static_assert(WS_XL + (size_t)MT * D * 4 <= WS_H && WS_H + (size_t)MT * D * 2 <= WS_P && WS_P + (size_t)MT * INC * 2 <= WS_MIX && WS_MIX + (size_t)MT * MIXW * 2 <= WS_ACT &&
              WS_ACT + (size_t)MAXTILES * 256 * FF * 2 <= WS_Y && WS_Y + (size_t)MT * 4 * D * 2 <= WS_END && WS_SLOT_GATE + (size_t)NE * CAP * 4 <= WS_WIN, "d_ws map");
constexpr int CW_TMO = 0, CW_CODE = 1;
constexpr int CW_BAR = 4096;
constexpr int CW_CNT = 8192;

constexpr int RING_BYTES = 131072;
constexpr int LDS_BYTES = 163840;
constexpr int MISC_OFF = LDS_BYTES - 512;
constexpr int TAB_OFF = LDS_BYTES - 4096;
constexpr int TAB_LCNT = TAB_OFF + 160, TAB_TINFO = TAB_OFF + 288;

#define GAS __attribute__((address_space(1)))
#define LAS __attribute__((address_space(3)))
typedef unsigned short bf16_t;
typedef short bf16x8 __attribute__((ext_vector_type(8)));
typedef float f32x4 __attribute__((ext_vector_type(4)));
typedef float f32x2 __attribute__((ext_vector_type(2)));
typedef unsigned u32x4 __attribute__((ext_vector_type(4)));
typedef unsigned u32x2 __attribute__((ext_vector_type(2)));
#define LDS_WAIT() asm volatile("s_waitcnt lgkmcnt(0)" ::: "memory")
#define VM_WAIT() asm volatile("s_waitcnt vmcnt(0)" ::: "memory")

__device__ __forceinline__ unsigned cvt_pk_bf16(float lo, float hi) { unsigned r; asm volatile("v_cvt_pk_bf16_f32 %0, %1, %2" : "=v"(r) : "v"(lo), "v"(hi)); return r; }
__device__ __forceinline__ float bf2f(unsigned short b) { return __uint_as_float(((unsigned)b) << 16); }
__device__ __forceinline__ float bflo(unsigned w) { return __uint_as_float(w << 16); }
__device__ __forceinline__ float bfhi(unsigned w) { return __uint_as_float(w & 0xffff0000u); }
__device__ __forceinline__ float wave_sum(float v) {
#pragma unroll
    for (int o = 1; o < 64; o <<= 1) v += __shfl_xor(v, o);
    return v;
}
__device__ __forceinline__ float gelu1(float v) {
    const float av = __builtin_fabsf(v), d = av * 0.2316418882f + 1.0f;
    const float t = __builtin_amdgcn_rcpf(d);
    float q = t * 0.5307027145f + (-0.7265760135f); q = q * t + 0.7107068705f; q = q * t + (-0.142248368f); q = q * t + 0.127414796f; q = q * t;
    const float s = (v * v) * (-0.72134752044f);
    const float e = __builtin_amdgcn_exp2f(s);
    const float m = v * (q * e), r = v - m;
    return v < 0.f ? m : r;
}

namespace pg8 {
constexpr int BM = 256, BK = 64, HALF = 128, HTB = HALF * BK * 2, STAGE_BYTES = 8 * HTB, NXCD = 8, WGM = 8;
__host__ __device__ __forceinline__ int lds_byte(int r, int c) { const int st = (r >> 4) * 2 + (c >> 5), rr = r & 15, cc = c & 31, ob = rr * 64 + cc * 2; return st * 1024 + (ob ^ (((ob >> 9) & 1) << 5)); }
__host__ __device__ __forceinline__ void stage_rc(int b, int& R, int& C) { const int st = b / 1024, sb = b % 1024, swz = sb ^ (((sb >> 9) & 1) << 5); R = (st >> 1) * 16 + swz / 64; C = (st & 1) * 32 + (swz % 64) / 2; }
__host__ __device__ __forceinline__ int perm32(int rho) { const int n = rho >> 4, i = rho & 15; return 8 * (i >> 2) + 4 * n + (i & 3); }

struct Unit { int pm, pn, e, mt; };

struct DenseSched {
    int nM, nN, nwg, G, c, K;
    __device__ void init(int M, int N, int K_, int G_, int c_) { nM = M / BM; nN = N / BM; nwg = nM * nN; G = G_; c = c_; K = K_; }
    __device__ __forceinline__ bool next(int i, Unit& u) const {
        const long L = (long)i * G + c; if (L >= nwg) return false;
        int wgid = (int)L; { const int q = nwg / NXCD, r = nwg % NXCD, xcd = wgid % NXCD, off = wgid / NXCD; wgid = (xcd < r ? xcd * (q + 1) : r * (q + 1) + (xcd - r) * q) + off; }
        const int nig = WGM * nN, gid = wgid / nig, fm = gid * WGM, gsz = (nM - fm) < WGM ? (nM - fm) : WGM;
        u.pm = fm + ((wgid % nig) % gsz); u.pn = (wgid % nig) / gsz; u.e = 0; u.mt = 0; return true;
    }
    __device__ __forceinline__ void a_off(const Unit& u, int tid, unsigned (&off)[2][2]) const {
#pragma unroll
        for (int i = 0; i < 2; ++i) { int R, C; stage_rc(tid * 16 + i * 8192, R, C);
#pragma unroll
            for (int h = 0; h < 2; ++h) off[h][i] = (unsigned)((u.pm * BM + h * HALF + R) * K + C) * 2u; }
    }
    __device__ __forceinline__ unsigned b_off(const Unit& u) const { return (unsigned)(u.pn * BM * K * 2); }
};
template <bool GATHER> struct MoeSched {
    const LAS int* tinfo; const LAS int* lcnt; const int* slot_tok; int nN, K, nunits, G, vcu; unsigned bstride;
    __device__ __forceinline__ bool next(int i, Unit& u) const {
        const int L = i * G + vcu; if (L >= nunits) return false;
        const int T = L / nN; u.pm = T; u.pn = L - T * nN;
        const int ti = __builtin_amdgcn_readfirstlane(tinfo[T]);
        u.e = ti & 255; u.mt = ti >> 8; return true;
    }
    __device__ __forceinline__ void a_off(const Unit& u, int tid, unsigned (&off)[2][2]) const {
        const int n = GATHER ? __builtin_amdgcn_readfirstlane(lcnt[u.e]) : 0;
#pragma unroll
        for (int i = 0; i < 2; ++i) { int R, C; stage_rc(tid * 16 + i * 8192, R, C);
#pragma unroll
            for (int h = 0; h < 2; ++h) {
                if constexpr (GATHER) { const int pos = u.mt * BM + h * HALF + R; const int row = pos < n ? slot_tok[u.e * CAP + pos] : 0; off[h][i] = (unsigned)(row * K + C) * 2u; }
                else off[h][i] = (unsigned)((u.pm * BM + h * HALF + R) * K + C) * 2u; } }
    }
    __device__ __forceinline__ unsigned b_off(const Unit& u) const { return (unsigned)u.e * bstride + (unsigned)(u.pn * BM * K * 2); }
};

template <class Epi, class Sched, bool ALIGN_EPI, bool SP2>
__device__ __forceinline__ void gemm_phase(LAS unsigned char* lds, const bf16_t* Aptr, const bf16_t* Btptr, int K, const Sched& S, const Epi& E) {
    int tid = threadIdx.x; asm volatile("" : "+v"(tid));
    const int wid = __builtin_amdgcn_readfirstlane(tid >> 6), lane = tid & 63, wr = wid >> 2, wc = wid & 3, fr = lane & 15, fq = lane >> 4;
    const int nt = K / BK;
    unsigned voffB[2];
#pragma unroll
    for (int i = 0; i < 2; ++i) { int R, C; stage_rc(tid * 16 + i * 8192, R, C); voffB[i] = (unsigned)(R * K + C) * 2u; }
    const unsigned kstep = (unsigned)(BK * 2);
    const unsigned hstep = (unsigned)(HALF * K * 2);
    const unsigned ldsw = (unsigned)wid * 1024u;
    const int aoff = lds_byte(wr * 64 + fr, fq * 8), boff = lds_byte(wc * 32 + fr, fq * 8);
    const char* Ab = (const char*)Aptr; const char* Bb = (const char*)Btptr;
#define PG8_SA(b, h) (((b) * 2 + (h)) * HTB)
#define PG8_SB(b, h) ((4 + (b) * 2 + (h)) * HTB)
#define PG8_STAGE_B(bufoff, sb) do { _Pragma("unroll") for (int _i = 0; _i < 2; ++_i) \
        __builtin_amdgcn_global_load_lds((const unsigned*)(Bb + (unsigned)(voffB[_i] + (sb))), (LAS unsigned*)(lds + (bufoff) + ldsw + _i * 8192), 16, 0, 0); } while (0)
#define PG8_STAGE_A(bufoff, o0, o1, kb) do { \
        __builtin_amdgcn_global_load_lds((const unsigned*)(Ab + (unsigned)((o0) + (kb))), (LAS unsigned*)(lds + (bufoff) + ldsw), 16, 0, 0); \
        __builtin_amdgcn_global_load_lds((const unsigned*)(Ab + (unsigned)((o1) + (kb))), (LAS unsigned*)(lds + (bufoff) + ldsw + 8192), 16, 0, 0); } while (0)
#define PG8_LDA(dst, b, h) do { _Pragma("unroll") for (int m = 0; m < 4; ++m) _Pragma("unroll") for (int k = 0; k < 2; ++k) dst[m][k] = *(const LAS bf16x8*)(lds + PG8_SA(b, h) + aoff + m * 2048 + k * 1024); } while (0)
#define PG8_LDB(dst, b, h) do { _Pragma("unroll") for (int n = 0; n < 2; ++n) _Pragma("unroll") for (int k = 0; k < 2; ++k) dst[n][k] = *(const LAS bf16x8*)(lds + PG8_SB(b, h) + boff + n * 2048 + k * 1024); } while (0)
#define PG8_MMA(ai, bj, At, Bt) do { __builtin_amdgcn_s_setprio(1); _Pragma("unroll") for (int m = 0; m < 4; ++m) _Pragma("unroll") for (int n = 0; n < 2; ++n) _Pragma("unroll") for (int k = 0; k < 2; ++k) \
        acc[ai][bj][m][n] = __builtin_amdgcn_mfma_f32_16x16x32_bf16(Bt[n][k], At[m][k], acc[ai][bj][m][n], 0, 0, 0); __builtin_amdgcn_s_setprio(0); } while (0)
#define PG8_WAIT_V(n) asm volatile("s_waitcnt vmcnt(" #n ")" ::: "memory")
#define PG8_WAIT_L(n) asm volatile("s_waitcnt lgkmcnt(" #n ")" ::: "memory")
#define PG8_BAR __builtin_amdgcn_s_barrier()
#define PG8_SCHED __builtin_amdgcn_sched_barrier(0)
    Unit cur, nxt; int ui = 0;
    if (!S.next(0, cur)) return;
    f32x4 acc[2][2][4][2];
#pragma unroll
    for (int a = 0; a < 2; ++a)
#pragma unroll
        for (int b = 0; b < 2; ++b)
#pragma unroll
            for (int m = 0; m < 4; ++m)
#pragma unroll
                for (int n = 0; n < 2; ++n) acc[a][b][m][n] = (f32x4){0.f, 0.f, 0.f, 0.f};
    bf16x8 At[4][2], B0[2][2], B1[2][2];
    unsigned offC[2][2];
    S.a_off(cur, tid, offC);
    unsigned cB = S.b_off(cur);
    if constexpr (SP2) {
        PG8_STAGE_B(PG8_SB(0, 0), cB); PG8_STAGE_B(PG8_SB(0, 1), cB + hstep); PG8_STAGE_A(PG8_SA(0, 0), offC[0][0], offC[0][1], 0u); PG8_STAGE_A(PG8_SA(0, 1), offC[1][0], offC[1][1], 0u);
        if (wr == 1) PG8_BAR;
        PG8_WAIT_V(2); PG8_BAR;
        PG8_STAGE_B(PG8_SB(1, 0), cB + kstep); PG8_STAGE_A(PG8_SA(1, 0), offC[0][0], offC[0][1], kstep); PG8_STAGE_B(PG8_SB(1, 1), cB + hstep + kstep);
        PG8_WAIT_V(6); PG8_BAR;
    } else {
        PG8_STAGE_B(PG8_SB(0, 0), cB); PG8_STAGE_A(PG8_SA(0, 0), offC[0][0], offC[0][1], 0u); PG8_STAGE_B(PG8_SB(0, 1), cB + hstep); PG8_STAGE_A(PG8_SA(0, 1), offC[1][0], offC[1][1], 0u);
        if (wr == 1) PG8_BAR;
        PG8_WAIT_V(4); PG8_BAR;
        PG8_STAGE_B(PG8_SB(1, 0), cB + kstep); PG8_STAGE_A(PG8_SA(1, 0), offC[0][0], offC[0][1], kstep); PG8_STAGE_B(PG8_SB(1, 1), cB + hstep + kstep);
        PG8_WAIT_V(6); PG8_BAR;
    }
    for (;;) {
        const bool has_next = S.next(ui + 1, nxt);
        const unsigned nB = has_next ? S.b_off(nxt) : cB;
        for (int t = 0; t < nt; t += 2) {
            const bool last = (t == nt - 2);
            const unsigned k1 = (unsigned)(t + 1) * kstep;
            const unsigned k2 = last ? 0u : (unsigned)(t + 2) * kstep, k3 = k2 + kstep;
            const unsigned b2 = last ? nB : cB + k2, b3 = b2 + kstep;
            if constexpr (SP2) {
            PG8_LDB(B0, 0, 0); PG8_LDB(B1, 0, 1); PG8_SCHED; PG8_LDA(At, 0, 0); PG8_STAGE_A(PG8_SA(1, 1), offC[1][0], offC[1][1], k1);
            if (last && has_next) S.a_off(nxt, tid, offC);
            PG8_WAIT_V(8); PG8_WAIT_L(0); PG8_BAR; PG8_MMA(0, 0, At, B0); PG8_MMA(0, 1, At, B1); PG8_BAR; PG8_SCHED;
            PG8_LDA(At, 0, 1); PG8_STAGE_B(PG8_SB(0, 0), b2); PG8_STAGE_B(PG8_SB(0, 1), b2 + hstep); PG8_STAGE_A(PG8_SA(0, 0), offC[0][0], offC[0][1], k2);
            PG8_WAIT_V(8); PG8_WAIT_L(0); PG8_BAR; PG8_MMA(1, 0, At, B0); PG8_MMA(1, 1, At, B1); PG8_BAR; PG8_SCHED;
            PG8_LDB(B0, 1, 0); PG8_LDB(B1, 1, 1); PG8_SCHED; PG8_LDA(At, 1, 0); PG8_STAGE_A(PG8_SA(0, 1), offC[1][0], offC[1][1], k2);
            PG8_WAIT_V(8); PG8_WAIT_L(0); PG8_BAR; PG8_MMA(0, 0, At, B0); PG8_MMA(0, 1, At, B1); PG8_BAR; PG8_SCHED;
            PG8_LDA(At, 1, 1); PG8_STAGE_B(PG8_SB(1, 0), b3); PG8_STAGE_B(PG8_SB(1, 1), b3 + hstep); PG8_STAGE_A(PG8_SA(1, 0), offC[0][0], offC[0][1], k3);
            PG8_WAIT_V(8); PG8_WAIT_L(0); PG8_BAR; PG8_MMA(1, 0, At, B0); PG8_MMA(1, 1, At, B1); PG8_BAR; PG8_SCHED;
            } else {
            PG8_LDB(B0, 0, 0); PG8_SCHED; PG8_LDA(At, 0, 0); PG8_STAGE_A(PG8_SA(1, 1), offC[1][0], offC[1][1], k1);
            if (last && has_next) S.a_off(nxt, tid, offC);
            PG8_WAIT_L(8); PG8_BAR; PG8_WAIT_L(0); PG8_MMA(0, 0, At, B0); PG8_BAR; PG8_SCHED;
            PG8_LDB(B1, 0, 1); PG8_STAGE_B(PG8_SB(0, 0), b2);
            PG8_BAR; PG8_WAIT_L(0); PG8_MMA(0, 1, At, B1); PG8_BAR;
            PG8_LDA(At, 0, 1); PG8_STAGE_A(PG8_SA(0, 0), offC[0][0], offC[0][1], k2);
            PG8_BAR; PG8_WAIT_L(0); PG8_MMA(1, 0, At, B0); PG8_BAR; PG8_SCHED;
            PG8_STAGE_B(PG8_SB(0, 1), b2 + hstep);
            PG8_WAIT_V(6); PG8_BAR; PG8_MMA(1, 1, At, B1); PG8_BAR;
            PG8_LDB(B0, 1, 0); PG8_SCHED; PG8_LDA(At, 1, 0); PG8_STAGE_A(PG8_SA(0, 1), offC[1][0], offC[1][1], k2);
            PG8_WAIT_L(8); PG8_BAR; PG8_WAIT_L(0); PG8_MMA(0, 0, At, B0); PG8_BAR; PG8_SCHED;
            PG8_LDB(B1, 1, 1); PG8_STAGE_B(PG8_SB(1, 0), b3);
            PG8_BAR; PG8_WAIT_L(0); PG8_MMA(0, 1, At, B1); PG8_BAR;
            PG8_LDA(At, 1, 1); PG8_STAGE_A(PG8_SA(1, 0), offC[0][0], offC[0][1], k3);
            PG8_BAR; PG8_WAIT_L(0); PG8_MMA(1, 0, At, B0); PG8_BAR; PG8_SCHED;
            PG8_STAGE_B(PG8_SB(1, 1), b3 + hstep);
            PG8_WAIT_V(6); PG8_BAR; PG8_MMA(1, 1, At, B1); PG8_BAR;
            }
        }
        if constexpr (ALIGN_EPI) { if (wr == 0) PG8_BAR; }
        E(acc, cur, wr, wc, fr, fq);
        if (!has_next) break;
#pragma unroll
        for (int a = 0; a < 2; ++a)
#pragma unroll
            for (int b = 0; b < 2; ++b)
#pragma unroll
                for (int m = 0; m < 4; ++m)
#pragma unroll
                    for (int n = 0; n < 2; ++n) acc[a][b][m][n] = (f32x4){0.f, 0.f, 0.f, 0.f};
        cur = nxt; cB = nB; ++ui;
        if constexpr (ALIGN_EPI) { if (wr == 1) PG8_BAR; }
    }
    PG8_WAIT_V(0);
    if constexpr (!ALIGN_EPI) { if (wr == 0) PG8_BAR; }
    PG8_BAR;
#undef PG8_SA
#undef PG8_SB
#undef PG8_STAGE_B
#undef PG8_STAGE_A
#undef PG8_LDA
#undef PG8_LDB
#undef PG8_MMA
#undef PG8_WAIT_V
#undef PG8_WAIT_L
#undef PG8_BAR
#undef PG8_SCHED
}

struct EpiWin {
    bf16_t* P; const float* cosT; const float* sinT;
    __device__ __forceinline__ void operator()(const f32x4 (&acc)[2][2][4][2], const Unit& u, int wr, int wc, int fr, int fq) const {
        const int row0 = u.pm * BM + wr * 64 + fr, colt = u.pn * BM + wc * 64 + fq * 8;
        const int mode = (u.pn < 2) ? 0 : (u.pn == 2 ? (wc < 2 ? 1 : 2) : (u.pn <= 4 ? 3 : 2));
        const bool rope = (mode <= 1) && (u.pm < TL / BM);
#pragma unroll
        for (int ai = 0; ai < 2; ++ai)
#pragma unroll
            for (int m = 0; m < 4; ++m) {
                const int r = row0 + ai * HALF + m * 16;
                f32x4 v[2][2];
#pragma unroll
                for (int bj = 0; bj < 2; ++bj)
#pragma unroll
                    for (int n = 0; n < 2; ++n) v[bj][n] = acc[ai][bj][m][n];
                if (rope) {
                    const int t = r & (S - 1); const int idx = (fq < 2) ? (t >> 6) : 256 + (t & 63); const int tb = idx * 16 + (fq & 1) * 8;
                    f32x4 cs[2], sn[2];
                    cs[0] = *(const f32x4*)(cosT + tb); cs[1] = *(const f32x4*)(cosT + tb + 4); sn[0] = *(const f32x4*)(sinT + tb); sn[1] = *(const f32x4*)(sinT + tb + 4);
#pragma unroll
                    for (int n = 0; n < 2; ++n) { const f32x4 x1 = v[0][n], x2 = v[1][n]; v[0][n] = x1 * cs[n] - x2 * sn[n]; v[1][n] = x1 * sn[n] + x2 * cs[n]; }
                }
                if (mode == 0) {
#pragma unroll
                    for (int bj = 0; bj < 2; ++bj)
#pragma unroll
                        for (int n = 0; n < 2; ++n) v[bj][n] = v[bj][n] * QSCALE;
                }
                if (mode == 3) {
#pragma unroll
                    for (int bj = 0; bj < 2; ++bj)
#pragma unroll
                        for (int n = 0; n < 2; ++n)
#pragma unroll
                            for (int g = 0; g < 4; ++g) v[bj][n][g] = gelu1(v[bj][n][g]);
                }
                bf16_t* rowp = P + (size_t)r * INC + colt;
#pragma unroll
                for (int bj = 0; bj < 2; ++bj) { u32x4 w; w.x = cvt_pk_bf16(v[bj][0][0], v[bj][0][1]); w.y = cvt_pk_bf16(v[bj][0][2], v[bj][0][3]); w.z = cvt_pk_bf16(v[bj][1][0], v[bj][1][1]); w.w = cvt_pk_bf16(v[bj][1][2], v[bj][1][3]);
                    *(u32x4*)(rowp + bj * 32) = w; }
            }
    }
};
struct EpiWout {
    const float* resL; const float* resC; float* XL; const float* g1;
    __device__ __forceinline__ void operator()(const f32x4 (&acc)[2][2][4][2], const Unit& u, int wr, int wc, int fr, int fq) const {
        const int row0 = u.pm * BM + wr * 64 + fr, col0 = u.pn * BM + wc * 32 + 4 * fq;
        const bool lat = u.pm < TL / BM; const int midx = lat ? (u.pm >> 6) : 2;
        const float* res = lat ? resL : resC - (size_t)TL * D;
        f32x4 gv[2][2];
#pragma unroll
        for (int bj = 0; bj < 2; ++bj)
#pragma unroll
            for (int n = 0; n < 2; ++n) gv[bj][n] = *(const f32x4*)(g1 + midx * 6144 + col0 + bj * HALF + n * 16);
#pragma unroll
        for (int ai = 0; ai < 2; ++ai)
#pragma unroll
            for (int m = 0; m < 4; ++m) { const size_t off = (size_t)(row0 + ai * HALF + m * 16) * D + col0;
#pragma unroll
                for (int bj = 0; bj < 2; ++bj)
#pragma unroll
                    for (int n = 0; n < 2; ++n) { const f32x4 x = *(const f32x4*)(res + off + bj * HALF + n * 16); *(f32x4*)(XL + off + bj * HALF + n * 16) = x + gv[bj][n] * acc[ai][bj][m][n]; } }
    }
};
struct EpiMoe1 {
    bf16_t* ACT; const float* b1;
    __device__ __forceinline__ void operator()(const f32x4 (&acc)[2][2][4][2], const Unit& u, int wr, int wc, int fr, int fq) const {
        const int row0 = u.pm * BM + wr * 64 + fr, f0 = u.pn * 128 + wc * 32 + fq * 8;
        f32x4 bb[4];
#pragma unroll
        for (int q = 0; q < 4; ++q) bb[q] = *(const f32x4*)(b1 + (size_t)u.e * FF2 + 2 * f0 + 4 * q);
#pragma unroll
        for (int ai = 0; ai < 2; ++ai)
#pragma unroll
            for (int m = 0; m < 4; ++m) { float a[8];
#pragma unroll
                for (int n = 0; n < 2; ++n)
#pragma unroll
                    for (int g = 0; g < 4; ++g) {
                        const float bg = bb[2 * n + (g >> 1)][2 * (g & 1)], bl = bb[2 * n + (g >> 1)][2 * (g & 1) + 1];
                        const float gg = __builtin_fminf(acc[ai][0][m][n][g] + bg, 7.0f);
                        const float ll = __builtin_fminf(__builtin_fmaxf(acc[ai][1][m][n][g] + bl, -7.0f), 7.0f);
                        const float sg = __builtin_amdgcn_rcpf(1.0f + __builtin_amdgcn_exp2f(gg * (-1.702f * LOG2E)));
                        a[4 * n + g] = gg * sg * (ll + 1.0f);
                    }
                u32x4 w; w.x = cvt_pk_bf16(a[0], a[1]); w.y = cvt_pk_bf16(a[2], a[3]); w.z = cvt_pk_bf16(a[4], a[5]); w.w = cvt_pk_bf16(a[6], a[7]);
                *(u32x4*)(ACT + (size_t)(row0 + ai * HALF + m * 16) * FF + f0) = w; }
    }
};
struct EpiMoe2 {
    bf16_t* Y; const float* b2; const int* slot_asg; const float* slot_gate; const LAS int* lcnt;
    __device__ __forceinline__ void operator()(const f32x4 (&acc)[2][2][4][2], const Unit& u, int wr, int wc, int fr, int fq) const {
        const int c0 = u.pn * BM + wc * 32 + fq * 8; const int n_e = __builtin_amdgcn_readfirstlane(lcnt[u.e]);
        f32x4 bv[2][2];
#pragma unroll
        for (int bj = 0; bj < 2; ++bj)
#pragma unroll
            for (int n = 0; n < 2; ++n) bv[bj][n] = *(const f32x4*)(b2 + (size_t)u.e * D + c0 + bj * HALF + 4 * n);
#pragma unroll
        for (int ai = 0; ai < 2; ++ai)
#pragma unroll
            for (int m = 0; m < 4; ++m) { const int pos = u.mt * BM + ai * HALF + wr * 64 + m * 16 + fr;
                if (pos < n_e) { const int asg = slot_asg[(size_t)u.e * CAP + pos]; const float gt = slot_gate[(size_t)u.e * CAP + pos];
                    bf16_t* rowp = Y + (size_t)asg * D + c0;
#pragma unroll
                    for (int bj = 0; bj < 2; ++bj) { const f32x4 v0 = (acc[ai][bj][m][0] + bv[bj][0]) * gt, v1 = (acc[ai][bj][m][1] + bv[bj][1]) * gt;
                        u32x4 w; w.x = cvt_pk_bf16(v0[0], v0[1]); w.y = cvt_pk_bf16(v0[2], v0[3]); w.z = cvt_pk_bf16(v1[0], v1[1]); w.w = cvt_pk_bf16(v1[2], v1[3]);
                        *(u32x4*)(rowp + bj * HALF) = w; } } }
    }
};
}

#define XB_TMO      128
#define XB_XCNT(j)  (256  + 64 * (j))
#define XB_XSUB(j)  (1280 + 64 * (j))
#define XB_XGEN(j)  (2304 + 64 * (j))
#define XB_TOP      3328
#define XB_TOPGEN   3392
#define XCD_BAR_WORDS 3456
#define XB_SPIN_CAP (1u << 18)
__device__ __forceinline__ unsigned xb_ld(unsigned* p)              { return __hip_atomic_load(p, __ATOMIC_RELAXED, __HIP_MEMORY_SCOPE_AGENT); }
__device__ __forceinline__ unsigned xb_add(unsigned* p, unsigned v) { return __hip_atomic_fetch_add(p, v, __ATOMIC_RELAXED, __HIP_MEMORY_SCOPE_AGENT); }
__device__ __forceinline__ unsigned xb_xcc_id() { return (unsigned)__builtin_amdgcn_s_getreg((3 << 11) | 20) & 0xFu; }
#define XB_SPIN(cond, bar) do { unsigned _sp = 0; while (cond) { __builtin_amdgcn_s_sleep(1); \
    if ((++_sp & 255u) == 0u) { if (xb_ld(&(bar)[XB_TMO])) break; if (_sp > XB_SPIN_CAP) { atomicAdd(&(bar)[XB_TMO], 1u); break; } } } } while (0)
struct XcdBarrier { unsigned* bar; unsigned x; volatile LAS unsigned* st; };
__device__ __forceinline__ XcdBarrier xcd_barrier_post(unsigned* bar, volatile LAS unsigned* st) {
    XcdBarrier b; b.bar = bar; b.x = xb_xcc_id(); b.st = st;
    if (threadIdx.x == 0) (void)xb_add(&bar[XB_XCNT(b.x)], 1u);
    return b;
}
__device__ __forceinline__ void xcd_barrier_complete(unsigned* bar, unsigned x, unsigned& nloc, unsigned& nx) {
    const unsigned G = gridDim.x * gridDim.y * gridDim.z;
    unsigned sum, cnt, mine, sp = 0u;
    for (;;) {
        sum = 0u; cnt = 0u; mine = 0u;
#pragma unroll
        for (unsigned j = 0; j < 16; ++j) { const unsigned c = xb_ld(&bar[XB_XCNT(j)]); sum += c; cnt += (c > 0u) ? 1u : 0u; mine = (j == x) ? c : mine; }
        if (sum == G) break;
        __builtin_amdgcn_s_sleep(1);
        if ((++sp & 255u) == 0u) { if (xb_ld(&bar[XB_TMO])) break; if (sp > XB_SPIN_CAP) { atomicAdd(&bar[XB_TMO], 1u); break; } }
    }
    nloc = mine > 0u ? mine : 1u; nx = cnt > 0u ? cnt : 1u;
}
__device__ __forceinline__ void xcd_barrier(const XcdBarrier& b) {
    asm volatile("s_waitcnt vmcnt(0)" ::: "memory");
    __syncthreads();
    if (threadIdx.x == 0) {
        unsigned* bar = b.bar;
        __builtin_amdgcn_s_waitcnt(0);
        unsigned nloc = b.st[0], nx = b.st[1];
        if (nloc == 0u) { xcd_barrier_complete(bar, b.x, nloc, nx); b.st[0] = nloc; b.st[1] = nx; }
        const unsigned old = xb_add(&bar[XB_XSUB(b.x)], 1u);
        const unsigned gen = old / nloc;
        if (old + 1u == (gen + 1u) * nloc) {
            __builtin_amdgcn_fence(__ATOMIC_RELEASE, "agent");
            asm volatile("s_waitcnt vmcnt(0)" ::: "memory");
            const unsigned og = xb_add(&bar[XB_TOP], 1u);
            const unsigned tg = og / nx;
            if (og + 1u == (tg + 1u) * nx) xb_add(&bar[XB_TOPGEN], 1u);
            else XB_SPIN(xb_ld(&bar[XB_TOPGEN]) == tg, bar);
            __builtin_amdgcn_fence(__ATOMIC_ACQUIRE, "agent");
            xb_add(&bar[XB_XGEN(b.x)], 1u);
            asm volatile("s_waitcnt vmcnt(0)" ::: "memory");
        } else {
            XB_SPIN(xb_ld(&bar[XB_XGEN(b.x)]) == gen, bar);
            __builtin_amdgcn_fence(__ATOMIC_ACQUIRE, "agent");
            asm volatile("s_waitcnt vmcnt(0)" ::: "memory");
        }
    }
    __syncthreads();
}

struct Args { const float* in[25]; float* out; unsigned char* ws; int ph_lo, ph_hi; };
struct Frame {
    LAS unsigned char* lds; volatile LAS unsigned* MISC; unsigned* ctl;
    int tid, lane, wave, vcu, G, bx;
    const __attribute__((address_space(4))) Args* ka; float* out; unsigned char* ws;
};
enum { I_X = 0, I_C, I_CTX, I_CCTX, I_N1G, I_N2G, I_ADAW, I_ADAB, I_WIN, I_SINK, I_SGUWS, I_SGUB, I_SGULNG, I_SGULNB, I_POOLW, I_POOLS, I_CONVW, I_WOUT, I_RW, I_RB, I_W1, I_B1, I_W2, I_B2, I_FG };

__device__ __forceinline__ void conv_item(const float* W, int ldw, int colbase, int cstride, bf16_t* Bt, int K, int prow0, int k0, bool perm, LAS float* scr, int lane) {
#pragma unroll 8
    for (int i = 0; i < 32; ++i) { const int kk = 2 * i + (lane >> 5); scr[kk * 33 + (lane & 31)] = W[(size_t)(k0 + kk) * ldw + colbase + (lane & 31) * cstride]; }
    LDS_WAIT(); asm volatile("" ::: "memory");
    const int c = lane & 7;
#pragma unroll
    for (int j = 0; j < 4; ++j) { const int n = (lane >> 3) + 8 * j; const int o = perm ? pg8::perm32(n) : n; const LAS float* s = scr + (8 * c) * 33 + o;
        u32x4 w; w.x = cvt_pk_bf16(s[0 * 33], s[1 * 33]); w.y = cvt_pk_bf16(s[2 * 33], s[3 * 33]); w.z = cvt_pk_bf16(s[4 * 33], s[5 * 33]); w.w = cvt_pk_bf16(s[6 * 33], s[7 * 33]);
        *(u32x4*)(Bt + (size_t)(prow0 + n) * K + k0 + 8 * c) = w; }
    LDS_WAIT(); asm volatile("" ::: "memory");
}
__device__ __forceinline__ void p0_prologue(Frame& F) {
    LAS float* scr = (LAS float*)(F.lds + F.wave * 16384);
    const int gw = F.vcu * 8 + F.wave, NGW = F.G * 8;
    constexpr int IT_WIN = (INC / 32) * (D / 64);
    constexpr int IT_WOUT = (D / 32) * (MIXW / 64);
    constexpr int IT_W1 = (FF2 / 32) * (D / 64);
    constexpr int IT_W2 = (D / 32) * (FF / 64);
    constexpr int N_WIN = DEPTH * IT_WIN, N_WOUT = DEPTH * IT_WOUT, N_W1 = DEPTH * NE * IT_W1, N_W2 = DEPTH * NE * IT_W2;
    constexpr int NITEMS = N_WIN + N_WOUT + N_W1 + N_W2;
    for (int it = gw; it < NITEMS; it += NGW) {
        int r = it;
        if (r < N_WIN) { const int l = r / IT_WIN; r -= l * IT_WIN; const int g = r / (D / 64), kb = r % (D / 64); const int pn = g >> 3, gi = g & 7, bj = gi >> 2, wc = gi & 3;
            conv_item(F.ka->in[I_WIN] + (size_t)l * D * INC, INC, pn * 256 + wc * 64 + bj * 32, 1, (bf16_t*)(F.ws + WS_WIN) + (size_t)l * INC * D, D, g * 32, kb * 64, true, scr, F.lane); continue; }
        r -= N_WIN;
        if (r < N_WOUT) { const int l = r / IT_WOUT; r -= l * IT_WOUT; const int g = r / (MIXW / 64), kb = r % (MIXW / 64);
            conv_item(F.ka->in[I_WOUT] + (size_t)l * MIXW * D, D, g * 32, 1, (bf16_t*)(F.ws + WS_WOUT) + (size_t)l * D * MIXW, MIXW, g * 32, kb * 64, false, scr, F.lane); continue; }
        r -= N_WOUT;
        if (r < N_W1) { const int le = r / IT_W1; r -= le * IT_W1; const int g = r / (D / 64), kb = r % (D / 64); const int pn = g >> 3, gi = g & 7, bj = gi >> 2, wc = gi & 3;
            conv_item(F.ka->in[I_W1] + (size_t)le * D * FF2, FF2, 2 * (pn * 128 + wc * 32) + bj, 2, (bf16_t*)(F.ws + WS_W1) + (size_t)le * FF2 * D, D, g * 32, kb * 64, true, scr, F.lane); continue; }
        r -= N_W1;
        { const int le = r / IT_W2; r -= le * IT_W2; const int g = r / (FF / 64), kb = r % (FF / 64);
            conv_item(F.ka->in[I_W2] + (size_t)le * FF * D, D, g * 32, 1, (bf16_t*)(F.ws + WS_W2) + (size_t)le * D * FF, FF, g * 32, kb * 64, true, scr, F.lane); }
    }
    __syncthreads();
    {
        LAS float* part = (LAS float*)F.lds;
        float* mod = (float*)(F.ws + WS_MOD);
        for (int task = F.vcu; task < DEPTH * 96; task += F.G) {
            const int l = task / 96, n0 = (task % 96) * 64;
            const float* aw = F.ka->in[I_ADAW] + (size_t)l * D * 6144 + n0 + F.lane;
            float a0 = 0.f, a1 = 0.f, a2 = 0.f;
#pragma unroll 8
            for (int kk = 0; kk < 128; ++kk) { const int k = F.wave * 128 + kk; const float w = aw[(size_t)k * 6144];
                const float c0 = F.ka->in[I_C][k], c1 = F.ka->in[I_C][D + k], c2 = F.ka->in[I_CCTX][k];
                a0 += w * (c0 / (1.f + __expf(-c0))); a1 += w * (c1 / (1.f + __expf(-c1))); a2 += w * (c2 / (1.f + __expf(-c2))); }
            part[(F.wave * 3 + 0) * 64 + F.lane] = a0; part[(F.wave * 3 + 1) * 64 + F.lane] = a1; part[(F.wave * 3 + 2) * 64 + F.lane] = a2;
            __syncthreads();
            if (F.tid < 192) { const int j = F.tid >> 6, n = F.tid & 63; float s = 0.f;
#pragma unroll
                for (int w = 0; w < 8; ++w) s += part[(w * 3 + j) * 64 + n];
                mod[(size_t)(l * 3 + j) * 6144 + n0 + n] = s + F.ka->in[I_ADAB][l * 6144 + n0 + n]; }
            __syncthreads();
        }
    }
    {
        float* cosT = (float*)(F.ws + WS_ROPE); float* sinT = cosT + 320 * 16;
        for (int i = F.vcu * 512 + F.tid; i < 320 * 16; i += F.G * 512) { const int p = i >> 4, d = i & 15; const int pos = p < 256 ? p : p - 256;
            const float inv = (float)exp2(-(double)d * (13.287712379549449 / 16.0));
            const float ang = (float)pos * inv;
            const double a = (double)ang;
            cosT[i] = (float)cos(a); sinT[i] = (float)sin(a); }
    }
}

__device__ __forceinline__ const float* xrow_in(const Frame& F, int layer, int r) {
    if (layer == 0) return r < TL ? F.ka->in[I_X] + (size_t)r * D : F.ka->in[I_CTX] + (size_t)(r - TL) * D;
    return (const float*)(F.ws + WS_XL) + (size_t)r * D;
}
__device__ __forceinline__ int mod_index(int r) { return r < TL ? (r >> 14) : 2; }

__device__ __forceinline__ void norm_mod_store(const f32x4 (&v)[4], const float* g, const float* shift, const float* scale, bf16_t* hrow, int lane) {
    float ss = 0.f;
#pragma unroll
    for (int j = 0; j < 4; ++j) ss += (v[j].x * v[j].x + v[j].y * v[j].y) + (v[j].z * v[j].z + v[j].w * v[j].w);
    const float rstd = 1.0f / sqrtf(wave_sum(ss) * (1.f / D) + EPS);
#pragma unroll
    for (int j = 0; j < 4; ++j) { const int c = 4 * lane + 256 * j;
        const f32x4 gg = *(const f32x4*)(g + c), sh = *(const f32x4*)(shift + c), sc = *(const f32x4*)(scale + c);
        const f32x4 y = (v[j] * rstd * gg) * (sc + 1.0f) + sh;
        u32x2 w; w.x = cvt_pk_bf16(y.x, y.y); w.y = cvt_pk_bf16(y.z, y.w);
        *(u32x2*)(hrow + c) = w; }
}
__device__ __forceinline__ void p_norm1_first(Frame& F) {
    const int gw = F.vcu * 8 + F.wave, NGW = F.G * 8;
    const float* mod = (const float*)(F.ws + WS_MOD);
    bf16_t* H = (bf16_t*)(F.ws + WS_H);
    for (int r = gw; r < MT; r += NGW) {
        const float* x = xrow_in(F, 0, r); const int mi = mod_index(r);
        f32x4 v[4];
#pragma unroll
        for (int j = 0; j < 4; ++j) v[j] = *(const f32x4*)(x + 4 * F.lane + 256 * j);
        norm_mod_store(v, F.ka->in[I_N1G], mod + (size_t)mi * 6144, mod + (size_t)mi * 6144 + D, H + (size_t)r * D, F.lane);
    }
}

__device__ __forceinline__ void attn_naive(Frame& F, int layer, int nrows) {
    const bf16_t* P = (const bf16_t*)(F.ws + WS_P); bf16_t* MIX = (bf16_t*)(F.ws + WS_MIX);
    const float* sink = F.ka->in[I_SINK] + layer * 8;
    const int ntask = (nrows / 64) * 8;
    const int gw = F.vcu * 8 + F.wave, NGW = F.G * 8;
    for (int task = gw; task < ntask; task += NGW) {
        const int hq = task & 7, rb = task >> 3; const int r0 = rb * 64, r = r0 + F.lane; const int kvh = hq >> 2;
        const bool lat = r0 < TL;
        float q[64], o[64];
        { const u32x4* qp = (const u32x4*)(P + (size_t)r * INC + PC_Q + hq * 64);
#pragma unroll
          for (int i = 0; i < 8; ++i) { const u32x4 w = qp[i]; q[8 * i + 0] = bflo(w.x); q[8 * i + 1] = bfhi(w.x); q[8 * i + 2] = bflo(w.y); q[8 * i + 3] = bfhi(w.y); q[8 * i + 4] = bflo(w.z); q[8 * i + 5] = bfhi(w.z); q[8 * i + 6] = bflo(w.w); q[8 * i + 7] = bfhi(w.w); } }
#pragma unroll
        for (int i = 0; i < 64; ++i) o[i] = 0.f;
        float m = sink[hq] * LOG2E, l = 1.0f;
        int kb0, kb1, seq0, b, cbase;
        if (lat) { b = r0 >> 14; seq0 = b * S; kb0 = r0 - 128; if (kb0 < seq0) kb0 = seq0; kb1 = r0 + 64 + 128; if (kb1 > seq0 + S) kb1 = seq0 + S; cbase = TL + b * LC; }
        else { b = (r0 - TL) >> 8; kb0 = 0; kb1 = 0; cbase = TL + b * LC; }
        const int nband = kb1 - kb0, nk = nband + LC;
        for (int j = 0; j < nk; ++j) {
            const int kr = j < nband ? kb0 + j : cbase + (j - nband);
            const u32x4* kp = (const u32x4*)(P + (size_t)kr * INC + PC_K + kvh * 64);
            float s = 0.f;
#pragma unroll
            for (int i = 0; i < 8; ++i) { const u32x4 w = kp[i]; s += q[8 * i + 0] * bflo(w.x) + q[8 * i + 1] * bfhi(w.x) + q[8 * i + 2] * bflo(w.y) + q[8 * i + 3] * bfhi(w.y) + q[8 * i + 4] * bflo(w.z) + q[8 * i + 5] * bfhi(w.z) + q[8 * i + 6] * bflo(w.w) + q[8 * i + 7] * bfhi(w.w); }
            bool valid = true;
            if (j < nband) { const int dd = r - kr; valid = (dd <= 128) && (dd >= -128); }
            if (valid) {
                const float mn = __builtin_fmaxf(m, s); const float alpha = __builtin_amdgcn_exp2f(m - mn), p = __builtin_amdgcn_exp2f(s - mn);
                l = l * alpha + p; m = mn;
                const u32x4* vp = (const u32x4*)(P + (size_t)kr * INC + PC_V + kvh * 64);
#pragma unroll
                for (int i = 0; i < 8; ++i) { const u32x4 w = vp[i];
                    o[8 * i + 0] = o[8 * i + 0] * alpha + p * bflo(w.x); o[8 * i + 1] = o[8 * i + 1] * alpha + p * bfhi(w.x); o[8 * i + 2] = o[8 * i + 2] * alpha + p * bflo(w.y); o[8 * i + 3] = o[8 * i + 3] * alpha + p * bfhi(w.y);
                    o[8 * i + 4] = o[8 * i + 4] * alpha + p * bflo(w.z); o[8 * i + 5] = o[8 * i + 5] * alpha + p * bfhi(w.z); o[8 * i + 6] = o[8 * i + 6] * alpha + p * bflo(w.w); o[8 * i + 7] = o[8 * i + 7] * alpha + p * bfhi(w.w); }
            }
        }
        const float rl = 1.0f / l;
        u32x4* op = (u32x4*)(MIX + (size_t)r * MIXW + hq * 64);
#pragma unroll
        for (int i = 0; i < 8; ++i) { u32x4 w; w.x = cvt_pk_bf16(o[8 * i + 0] * rl, o[8 * i + 1] * rl); w.y = cvt_pk_bf16(o[8 * i + 2] * rl, o[8 * i + 3] * rl); w.z = cvt_pk_bf16(o[8 * i + 4] * rl, o[8 * i + 5] * rl); w.w = cvt_pk_bf16(o[8 * i + 6] * rl, o[8 * i + 7] * rl); op[i] = w; }
    }
}

__device__ __forceinline__ void gated_chunk(Frame& F, int layer, int chunk) {
    const bf16_t* P = (const bf16_t*)(F.ws + WS_P); bf16_t* MIX = (bf16_t*)(F.ws + WS_MIX);
    const int R0 = chunk * 128; const bool lat = R0 < TL;
    const int seq0 = lat ? (R0 & ~(S - 1)) : TL + ((R0 - TL) & ~(LC - 1)); const int nseq = lat ? S : LC;
    int tid = F.tid; asm volatile("" : "+v"(tid)); const int lane = tid & 63, wave = F.wave;
    {
        LAS float* vn = (LAS float*)F.lds;
        const float* lng = F.ka->in[I_SGULNG] + layer * 256; const float* lnb = F.ka->in[I_SGULNB] + layer * 256;
        for (int rr = wave; rr < 128; rr += 8) {
            const bf16_t* vp = P + (size_t)(R0 + rr) * INC + PC_SV + 4 * lane;
            const u32x2 w = *(const u32x2*)vp; float x[4] = {bflo(w.x), bfhi(w.x), bflo(w.y), bfhi(w.y)};
            const float mu = wave_sum((x[0] + x[1]) + (x[2] + x[3])) * (1.f / 256.f);
            float q = 0.f;
#pragma unroll
            for (int i = 0; i < 4; ++i) { x[i] -= mu; q += x[i] * x[i]; }
            const float rstd = 1.0f / sqrtf(wave_sum(q) * (1.f / 256.f) + EPS);
#pragma unroll
            for (int i = 0; i < 4; ++i) vn[rr * 257 + 4 * lane + i] = x[i] * rstd * lng[4 * lane + i] + lnb[4 * lane + i];
        }
        __syncthreads();
        const int c = tid & 255, ph = tid >> 8, h = __builtin_amdgcn_readfirstlane(c >> 6);
        const float* wsm = F.ka->in[I_SGUWS] + ((size_t)layer * 4 + h) * 128 * 128; const float* bsv = F.ka->in[I_SGUB] + (layer * 4 + h) * 128;
        for (int pg = 0; pg < 16; ++pg) { const int p0 = ph * 64 + pg * 4;
            float a[4] = {0.f, 0.f, 0.f, 0.f};
#pragma unroll 2
            for (int r4 = 0; r4 < 32; ++r4) {
                const float v0 = vn[(4 * r4 + 0) * 257 + c], v1 = vn[(4 * r4 + 1) * 257 + c], v2 = vn[(4 * r4 + 2) * 257 + c], v3 = vn[(4 * r4 + 3) * 257 + c];
#pragma unroll
                for (int i = 0; i < 4; ++i) { const f32x4 w = *(const f32x4*)(wsm + (size_t)(p0 + i) * 128 + 4 * r4); a[i] += (w.x * v0 + w.y * v1) + (w.z * v2 + w.w * v3); } }
#pragma unroll
            for (int i = 0; i < 4; ++i) { const int p = p0 + i; const float sv = a[i] + bsv[p];
                const float uu = bf2f(P[(size_t)(R0 + p) * INC + PC_SU + c]);
                MIX[(size_t)(R0 + p) * MIXW + 512 + c] = (unsigned short)(cvt_pk_bf16(uu * sv, 0.f) & 0xffffu); } }
        __syncthreads();
    }
    {
        LAS float* xs = (LAS float*)F.lds; LAS float* dd = (LAS float*)(F.lds + 80 * 256 * 4);
        const float* pw = F.ka->in[I_POOLW] + (size_t)layer * 4 * 64 * 64; const float* psc = F.ka->in[I_POOLS] + layer * 256;
        const int co = tid & 255, ph = tid >> 8, gi = co >> 6, dcol = co & 63;
        float pwc[64];
#pragma unroll
        for (int cc = 0; cc < 64; ++cc) pwc[cc] = pw[((size_t)gi * 64 + cc) * 64 + dcol];
        const float pscale = psc[co];
        for (int half = 0; half < 2; ++half) {
            const int r0 = R0 + half * 64;
            for (int i = tid; i < 80 * 64; i += 512) { const int rr = i >> 6, c4 = (i & 63) * 4; const int gr = r0 - 8 + rr;
                f32x4 x = (f32x4){0.f, 0.f, 0.f, 0.f};
                if (gr >= seq0 && gr < seq0 + nseq) { const u32x2 w = *(const u32x2*)(P + (size_t)gr * INC + PC_XP + c4); x = (f32x4){bflo(w.x), bfhi(w.x), bflo(w.y), bfhi(w.y)}; }
                *(LAS f32x4*)(xs + rr * 256 + c4) = x; }
            __syncthreads();
            for (int i = tid; i < 64 * 256; i += 512) { const int rr = i >> 8, c = i & 255; const int g = c >> 6, w = 2 << g; const int t = r0 + rr - seq0;
                int lo = t - (w >> 1), hi = t + (w >> 1); if (lo < 0) lo = 0; if (hi > nseq) hi = nseq;
                float s = 0.f;
                for (int j = lo; j < hi; ++j) s += xs[(j - t + rr + 8) * 256 + c];
                dd[rr * 256 + c] = s / (float)(hi - lo) - xs[(rr + 8) * 256 + c]; }
            __syncthreads();
            for (int rr = ph * 32; rr < ph * 32 + 32; ++rr) { const LAS float* dr = dd + rr * 256 + gi * 64; float a0 = 0.f, a1 = 0.f;
#pragma unroll
                for (int cc = 0; cc < 64; cc += 2) { a0 += dr[cc] * pwc[cc]; a1 += dr[cc + 1] * pwc[cc + 1]; }
                MIX[(size_t)(r0 + rr) * MIXW + 768 + co] = (unsigned short)(cvt_pk_bf16((a0 + a1) * pscale, 0.f) & 0xffffu); }
            __syncthreads();
        }
    }
    {
        const float* cw = F.ka->in[I_CONVW] + layer * 3 * 256;
        for (int i = tid; i < 128 * 64; i += 512) { const int rr = i >> 6, c4 = (i & 63) * 4; const int gr = R0 + rr;
            f32x4 z = (f32x4){0.f, 0.f, 0.f, 0.f};
#pragma unroll
            for (int j = 0; j < 3; ++j) { const int kr = gr + j - 1;
                if (kr >= seq0 && kr < seq0 + nseq) { const u32x2 a = *(const u32x2*)(P + (size_t)kr * INC + PC_CC + c4), b = *(const u32x2*)(P + (size_t)kr * INC + PC_CX + c4);
                    const f32x4 wv = *(const f32x4*)(cw + j * 256 + c4);
                    z += wv * ((f32x4){bflo(a.x), bfhi(a.x), bflo(a.y), bfhi(a.y)} * (f32x4){bflo(b.x), bfhi(b.x), bflo(b.y), bfhi(b.y)}); } }
            const u32x2 cbv = *(const u32x2*)(P + (size_t)gr * INC + PC_CB + c4);
            z = z * (f32x4){bflo(cbv.x), bfhi(cbv.x), bflo(cbv.y), bfhi(cbv.y)};
            u32x2 w; w.x = cvt_pk_bf16(z.x, z.y); w.y = cvt_pk_bf16(z.z, z.w);
            *(u32x2*)(MIX + (size_t)gr * MIXW + 1024 + c4) = w; }
    }
    __syncthreads();
}

__device__ __forceinline__ void p_router(Frame& F, int layer, int nrows) {
    LAS float* rw = (LAS float*)F.lds;
    LAS int* lst_e = (LAS int*)(F.lds + 147456);
    LAS int* lst_r = lst_e + 136 * 4; LAS float* lst_g = (LAS float*)(lst_r + 136 * 4);
    LAS int* hist = (LAS int*)(lst_g + 136 * 4); LAS int* base = hist + 32;
    const float* rwg = F.ka->in[I_RW] + (size_t)layer * D * NE; const float* rb = F.ka->in[I_RB] + layer * NE;
    for (int i = F.tid; i < D * NE / 4; i += 512) { const int c = i >> 3, e4 = (i & 7) * 4; *(LAS f32x4*)(rw + c * 36 + e4) = *(const f32x4*)(rwg + c * 32 + e4); }
    if (F.tid < 32) hist[F.tid] = 0;
    __syncthreads();
    const float* mod = (const float*)(F.ws + WS_MOD) + (size_t)layer * 3 * 6144;
    const float* XL = (const float*)(F.ws + WS_XL); bf16_t* H = (bf16_t*)(F.ws + WS_H);
    const float* g2n = F.ka->in[I_N2G] + layer * D;
    const int lane = F.lane;
    int jl = F.wave;
    for (; F.vcu + F.G * jl < nrows; jl += 8) {
        const int r = F.vcu + F.G * jl; const int mi = mod_index(r);
        const float* x = XL + (size_t)r * D; const float* sh = mod + (size_t)mi * 6144 + 3 * D; const float* sc = mod + (size_t)mi * 6144 + 4 * D;
        float v[16]; float ss = 0.f;
#pragma unroll
        for (int j = 0; j < 16; ++j) { v[j] = x[lane + 64 * j]; ss += v[j] * v[j]; }
        const float rstd = 1.0f / sqrtf(wave_sum(ss) * (1.f / D) + EPS);
        float lg[32];
#pragma unroll
        for (int e = 0; e < 32; ++e) lg[e] = 0.f;
#pragma unroll
        for (int j = 0; j < 16; ++j) { const int c = lane + 64 * j;
            const float y = (v[j] * rstd * g2n[c]) * (1.0f + sc[c]) + sh[c];
            H[(size_t)r * D + c] = (unsigned short)(cvt_pk_bf16(y, 0.f) & 0xffffu);
            const LAS f32x4* wr = (const LAS f32x4*)(rw + c * 36);
#pragma unroll
            for (int e4 = 0; e4 < 8; ++e4) { const f32x4 w = wr[e4]; lg[4 * e4] += y * w.x; lg[4 * e4 + 1] += y * w.y; lg[4 * e4 + 2] += y * w.z; lg[4 * e4 + 3] += y * w.w; } }
#pragma unroll
        for (int e = 0; e < 32; ++e) lg[e] = wave_sum(lg[e]) + rb[e];
        int te[4]; float tv[4];
#pragma unroll
        for (int k = 0; k < 4; ++k) { float best = -3.0e38f; int bi = 0;
#pragma unroll
            for (int e = 0; e < 32; ++e) { const bool tk = lg[e] > best; best = tk ? lg[e] : best; bi = tk ? e : bi; }
            te[k] = bi; tv[k] = best;
#pragma unroll
            for (int e = 0; e < 32; ++e) lg[e] = (e == bi) ? -3.0e38f : lg[e]; }
        const float e1 = __expf(tv[1] - tv[0]), e2 = __expf(tv[2] - tv[0]), e3 = __expf(tv[3] - tv[0]); const float inv = 1.0f / (1.0f + e1 + e2 + e3);
        const float gt[4] = {inv, e1 * inv, e2 * inv, e3 * inv};
        if (lane < 4) { const int ee = lane == 0 ? te[0] : lane == 1 ? te[1] : lane == 2 ? te[2] : te[3]; const float gg = lane == 0 ? gt[0] : lane == 1 ? gt[1] : lane == 2 ? gt[2] : gt[3];
            const int rk = __hip_atomic_fetch_add(hist + ee, 1, __ATOMIC_RELAXED, __HIP_MEMORY_SCOPE_WORKGROUP);
            lst_e[jl * 4 + lane] = ee; lst_r[jl * 4 + lane] = rk; lst_g[jl * 4 + lane] = gg; }
    }
    __syncthreads();
    unsigned* cnt = F.ctl + CW_CNT + layer * NE * 16;
    if (F.tid < 32) base[F.tid] = (int)__hip_atomic_fetch_add(cnt + F.tid * 16, (unsigned)hist[F.tid], __ATOMIC_RELAXED, __HIP_MEMORY_SCOPE_AGENT);
    __syncthreads();
    int* slot_tok = (int*)(F.ws + WS_SLOT_TOK); int* slot_asg = (int*)(F.ws + WS_SLOT_ASG); float* slot_gate = (float*)(F.ws + WS_SLOT_GATE);
    const int nloc = (nrows - F.vcu + F.G - 1) / F.G;
    for (int i = F.tid; i < nloc * 4; i += 512) { const int j = i >> 2, k = i & 3; const int r = F.vcu + F.G * j; const int e = lst_e[i]; const int pos = base[e] + lst_r[i];
        slot_tok[(size_t)e * CAP + pos] = r; slot_asg[(size_t)e * CAP + pos] = r * 4 + k; slot_gate[(size_t)e * CAP + pos] = lst_g[i]; }
    __syncthreads();
}

__device__ __forceinline__ int moe_tables(Frame& F, int layer) {
    LAS int* tstart = (LAS int*)(F.lds + TAB_OFF); LAS int* lcnt = (LAS int*)(F.lds + TAB_LCNT); LAS int* tinfo = (LAS int*)(F.lds + TAB_TINFO);
    unsigned* cnt = F.ctl + CW_CNT + layer * NE * 16;
    if (F.tid == 0) { int acc = 0; for (int e = 0; e < NE; ++e) { const int n = (int)__hip_atomic_load(cnt + e * 16, __ATOMIC_RELAXED, __HIP_MEMORY_SCOPE_AGENT); lcnt[e] = n; tstart[e] = acc; acc += (n + 255) >> 8; } tstart[NE] = acc; }
    __syncthreads();
    const int nt = tstart[NE];
    for (int T = F.tid; T < nt; T += 512) { int e = 0; for (int j = 1; j < NE; ++j) e += (T >= tstart[j]) ? 1 : 0; tinfo[T] = e | ((T - tstart[e]) << 8); }
    __syncthreads();
    return __builtin_amdgcn_readfirstlane(nt);
}

__device__ __forceinline__ void p_combine(Frame& F, int layer, int nrows) {
    const int gw = F.vcu * 8 + F.wave, NGW = F.G * 8; const int lane = F.lane;
    const float* mod = (const float*)(F.ws + WS_MOD);
    float* XL = (float*)(F.ws + WS_XL); const bf16_t* Y = (const bf16_t*)(F.ws + WS_Y); bf16_t* H = (bf16_t*)(F.ws + WS_H);
    const bool last = layer == DEPTH - 1;
    for (int r = gw; r < nrows; r += NGW) {
        const int mi = mod_index(r); const float* g2 = mod + (size_t)(layer * 3 + mi) * 6144 + 5 * D;
        f32x4 v[4];
#pragma unroll
        for (int j = 0; j < 4; ++j) { const int c = 4 * lane + 256 * j; f32x4 s = (f32x4){0.f, 0.f, 0.f, 0.f};
#pragma unroll
            for (int k = 0; k < 4; ++k) { const u32x2 w = *(const u32x2*)(Y + (size_t)(r * 4 + k) * D + c); s += (f32x4){bflo(w.x), bfhi(w.x), bflo(w.y), bfhi(w.y)}; }
            v[j] = *(const f32x4*)(XL + (size_t)r * D + c) + *(const f32x4*)(g2 + c) * s; }
        if (!last) {
#pragma unroll
            for (int j = 0; j < 4; ++j) *(f32x4*)(XL + (size_t)r * D + 4 * lane + 256 * j) = v[j];
            const float* m1 = mod + (size_t)((layer + 1) * 3 + mi) * 6144;
            norm_mod_store(v, F.ka->in[I_N1G] + (layer + 1) * D, m1, m1 + D, H + (size_t)r * D, lane);
        } else {
            float ss = 0.f;
#pragma unroll
            for (int j = 0; j < 4; ++j) ss += (v[j].x * v[j].x + v[j].y * v[j].y) + (v[j].z * v[j].z + v[j].w * v[j].w);
            const float rstd = 1.0f / sqrtf(wave_sum(ss) * (1.f / D) + EPS);
#pragma unroll
            for (int j = 0; j < 4; ++j) { const int c = 4 * lane + 256 * j; *(f32x4*)(F.out + (size_t)r * D + c) = v[j] * rstd * *(const f32x4*)(F.ka->in[I_FG] + c); }
        }
    }
}

__global__ void __launch_bounds__(512, 2) fwd_kernel(Args args) {
    extern __shared__ __attribute__((aligned(16))) unsigned char lds[];
    Frame F;
#define FRESH() do { int t_ = threadIdx.x; asm volatile("" : "+v"(t_)); F.tid = t_; F.lane = t_ & 63; F.wave = __builtin_amdgcn_readfirstlane(t_ >> 6); \
        int g_ = gridDim.x, b_ = blockIdx.x; asm volatile("" : "+s"(g_), "+s"(b_)); F.G = g_; F.bx = b_; F.vcu = (g_ % 8 == 0) ? (b_ % 8) * (g_ / 8) + b_ / 8 : b_; \
        const __attribute__((address_space(4))) Args* k_ = (const __attribute__((address_space(4))) Args*)__builtin_amdgcn_kernarg_segment_ptr(); asm volatile("" : "+s"(k_)); F.ka = k_; \
        unsigned char* w_ = k_->ws; F.ws = w_; F.ctl = (unsigned*)(w_ + WS_CTL); F.out = k_->out; \
        F.lds = (LAS unsigned char*)lds; F.MISC = (volatile LAS unsigned*)(F.lds + MISC_OFF); } while (0)
    FRESH();
    for (int u = F.tid; u < 128; u += 512) ((LAS unsigned*)(F.lds + MISC_OFF))[u] = 0u;
    __syncthreads();
    XcdBarrier bar; bar.bar = F.ctl + CW_BAR; bar.x = 0; bar.st = nullptr;
    const int lo = F.ka->ph_lo, hi = F.ka->ph_hi;
    const bool one_launch = (hi - lo) > 1;
    if (one_launch) bar = xcd_barrier_post(F.ctl + CW_BAR, F.MISC + 8);
#define IN(k) (lo <= (k) && (k) < hi)
#define PH(k) if (IN(k)) FRESH(); if (IN(k))
#define SEAM(k) do { if (IN(k) && IN((k) + 1)) xcd_barrier(bar); } while (0)

    PH(0) { p0_prologue(F); } SEAM(0);
    PH(1) { p_norm1_first(F); } SEAM(1);
    for (int l = 0; l < DEPTH; ++l) {
        const int pb = 2 + 7 * l;
        const bool lastl = (l == DEPTH - 1);
        const int nrows = lastl ? TL : MT;
        PH(pb + 0) {
            pg8::DenseSched Sd; Sd.init(MT, INC, D, F.G, F.bx);
            pg8::EpiWin E{(bf16_t*)(F.ws + WS_P), (const float*)(F.ws + WS_ROPE), (const float*)(F.ws + WS_ROPE) + 320 * 16};
            pg8::gemm_phase<pg8::EpiWin, pg8::DenseSched, true, true>(F.lds, (const bf16_t*)(F.ws + WS_H), (const bf16_t*)(F.ws + WS_WIN) + (size_t)l * INC * D, D, Sd, E);
        }
        SEAM(pb + 0);
        PH(pb + 1) {
            attn_naive(F, l, nrows);
            __syncthreads();
            for (int ch = F.vcu; ch < nrows / 128; ch += F.G) gated_chunk(F, l, ch);
        }
        SEAM(pb + 1);
        PH(pb + 2) {
            pg8::DenseSched Sd; Sd.init(nrows, D, MIXW, F.G, F.bx);
            const float* resL = (l == 0) ? F.ka->in[I_X] : (const float*)(F.ws + WS_XL);
            const float* resC = (l == 0) ? F.ka->in[I_CTX] : (const float*)(F.ws + WS_XL) + (size_t)TL * D;
            pg8::EpiWout E{resL, resC, (float*)(F.ws + WS_XL), (const float*)(F.ws + WS_MOD) + (size_t)l * 3 * 6144 + 2 * D};
            pg8::gemm_phase<pg8::EpiWout, pg8::DenseSched, true, true>(F.lds, (const bf16_t*)(F.ws + WS_MIX), (const bf16_t*)(F.ws + WS_WOUT) + (size_t)l * D * MIXW, MIXW, Sd, E);
        }
        SEAM(pb + 2);
        PH(pb + 3) { p_router(F, l, nrows); }
        SEAM(pb + 3);
        PH(pb + 4) {
            const int ntiles = moe_tables(F, l);
            pg8::MoeSched<true> Sm{(const LAS int*)(F.lds + TAB_TINFO), (const LAS int*)(F.lds + TAB_LCNT), (const int*)(F.ws + WS_SLOT_TOK), FF2 / 256, D, ntiles * (FF2 / 256), F.G, F.vcu, (unsigned)(FF2 * D * 2)};
            pg8::EpiMoe1 E{(bf16_t*)(F.ws + WS_ACT), F.ka->in[I_B1] + (size_t)l * NE * FF2};
            pg8::gemm_phase<pg8::EpiMoe1, pg8::MoeSched<true>, true, true>(F.lds, (const bf16_t*)(F.ws + WS_H), (const bf16_t*)(F.ws + WS_W1) + (size_t)l * NE * FF2 * D, D, Sm, E);
        }
        SEAM(pb + 4);
        PH(pb + 5) {
            const int ntiles = moe_tables(F, l);
            pg8::MoeSched<false> Sm{(const LAS int*)(F.lds + TAB_TINFO), (const LAS int*)(F.lds + TAB_LCNT), nullptr, D / 256, FF, ntiles * (D / 256), F.G, F.vcu, (unsigned)(D * FF * 2)};
            pg8::EpiMoe2 E{(bf16_t*)(F.ws + WS_Y), F.ka->in[I_B2] + (size_t)l * NE * D, (const int*)(F.ws + WS_SLOT_ASG), (const float*)(F.ws + WS_SLOT_GATE), (const LAS int*)(F.lds + TAB_LCNT)};
            pg8::gemm_phase<pg8::EpiMoe2, pg8::MoeSched<false>, true, true>(F.lds, (const bf16_t*)(F.ws + WS_ACT), (const bf16_t*)(F.ws + WS_W2) + (size_t)l * NE * D * FF, FF, Sm, E);
        }
        SEAM(pb + 5);
        PH(pb + 6) { p_combine(F, l, nrows); }
        if (!lastl) SEAM(pb + 6);
    }
#undef IN
#undef SEAM
}

extern "C" void kernel_launch(void* const* d_in, const int* in_sizes, int n_in, void* d_out, int out_size, void* d_ws, size_t ws_size, hipStream_t stream) {
    static int grid = 0;
    if (grid == 0) {
        if (n_in != 25 || out_size != TL * D || ws_size < WS_END) { fprintf(stderr, "kernel_launch: unexpected problem (n_in %d, out %d, ws %zu)\n", n_in, out_size, ws_size); grid = -1; return; }
        int dev = 0, cus = 0, per_cu = 0;
        if (hipGetDevice(&dev) != hipSuccess || hipDeviceGetAttribute(&cus, hipDeviceAttributeMultiprocessorCount, dev) != hipSuccess) { grid = -1; return; }
        if (hipFuncSetAttribute((const void*)fwd_kernel, hipFuncAttributeMaxDynamicSharedMemorySize, LDS_BYTES) != hipSuccess) { fprintf(stderr, "kernel_launch: hipFuncSetAttribute failed\n"); grid = -1; return; }
        if (hipOccupancyMaxActiveBlocksPerMultiprocessor(&per_cu, (const void*)fwd_kernel, 512, LDS_BYTES) != hipSuccess || per_cu < 1) fprintf(stderr, "kernel_launch: occupancy query reports %d\n", per_cu);
        (void)hipGetLastError();
        grid = cus;
    }
    if (grid < 0) return;
    if (hipMemsetAsync((char*)d_ws + WS_CTL, 0, CTL_ZERO_BYTES, stream) != hipSuccess) return;
    Args a{};
    for (int i = 0; i < 25; ++i) a.in[i] = (const float*)d_in[i];
    a.out = (float*)d_out; a.ws = (unsigned char*)d_ws;
    constexpr int NL = MK_N_LAUNCHES;
    static_assert(NL == 1 || NL == NPHASES, "MK_N_LAUNCHES: 1 or one per phase");
    for (int li = 0; li < NL; ++li) {
        a.ph_lo = (NL == 1) ? 0 : li; a.ph_hi = (NL == 1) ? NPHASES : li + 1;
        hipLaunchKernelGGL(fwd_kernel, dim3(grid), dim3(512), LDS_BYTES, stream, a);
        if (hipPeekAtLastError() != hipSuccess) { fprintf(stderr, "kernel_launch: launch %d failed\n", li); break; }
    }
}
```

```cpp
#include <hip/hip_runtime.h>
#include <cstdio>
#include <cstdint>

#ifndef REPEAT_MASK
#define REPEAT_MASK 0x0
#endif
#ifndef FP8_MOE1
#define FP8_MOE1 1
#endif
#ifndef FP8_MOE2
#define FP8_MOE2 1
#endif
#ifndef FP8_IMG
#define FP8_IMG 0
#endif
#ifndef FP8_WOUT
#define FP8_WOUT 1
#endif
#ifndef ATTN_PAIR
#define ATTN_PAIR 1
#endif
#ifndef SK_FP8
#define SK_FP8 1
#endif
#ifndef SP2_FP8
#define SP2_FP8 1
#endif
#ifndef MK_N_LAUNCHES
#define MK_N_LAUNCHES 1
#endif

constexpr int D = 1024, NB = 2, S = 16384, LC = 256, DEPTH = 2;
constexpr int TL = NB * S, TC = NB * LC, MT = TL + TC;
constexpr int INC = 2304, MIXW = 1280, NE = 32, FF = 1024, FF2 = 2048;
constexpr int CAP = MT;
constexpr int MAXTILES = (MT * 4) / 256 + NE;
constexpr int NPHASES = 2 + 7 * DEPTH;
constexpr float EPS = 1e-6f;
constexpr float LOG2E = 1.4426950408889634f;
constexpr float QSCALE = 0.125f * LOG2E;
constexpr int PC_Q = 0, PC_K = 512, PC_V = 640, PC_SU = 768, PC_SV = 1024, PC_XP = 1280, PC_CB = 1536, PC_CC = 1792, PC_CX = 2048;

constexpr size_t MiB = 1u << 20;
constexpr size_t WS_CTL = 0, CTL_ZERO_BYTES = 1 * MiB;
constexpr size_t WS_MOD = 1 * MiB;
constexpr size_t WS_ROPE = 1 * MiB + 512 * 1024;
constexpr size_t WS_SLOT_TOK = 2 * MiB, WS_SLOT_ASG = 7 * MiB, WS_SLOT_GATE = 12 * MiB;
constexpr size_t WS_WIN = 17 * MiB;
constexpr size_t WS_WOUT = 26 * MiB;
constexpr size_t WS_W1 = 32 * MiB;
constexpr size_t WS_W2 = 288 * MiB;
constexpr size_t WS_XL = 416 * MiB;
constexpr size_t WS_H = 547 * MiB;
constexpr size_t WS_P = 613 * MiB;
constexpr size_t WS_MIX = 760 * MiB;
constexpr size_t WS_ACT = 842 * MiB;
constexpr size_t WS_Y = 1119 * MiB;
constexpr size_t WS_KF = 1380 * MiB;
constexpr size_t WS_VF = 1389 * MiB;
constexpr size_t WS_SGUW = 1398 * MiB;
constexpr size_t WS_POOLWT = 1399 * MiB;
constexpr size_t WS_RWP = 1400 * MiB;
constexpr size_t WS_BIASP = 1401 * MiB;
constexpr size_t WS_H8 = 1402 * MiB;
constexpr size_t WS_DX = 1436 * MiB;
constexpr size_t WS_END = 1502 * MiB;
constexpr int NT32 = MT / 32;
static_assert(WS_XL + (size_t)MT * D * 4 <= WS_H && WS_H + (size_t)MT * D * 2 <= WS_P && WS_P + (size_t)MT * INC * 2 <= WS_MIX && WS_MIX + (size_t)MT * MIXW * 2 <= WS_ACT &&
              WS_ACT + (size_t)MAXTILES * 256 * FF * 2 <= WS_Y && WS_Y + (size_t)MT * 4 * D * 2 <= WS_END && WS_SLOT_GATE + (size_t)NE * CAP * 4 <= WS_WIN, "d_ws map");
constexpr int CW_TMO = 0, CW_CODE = 1;
constexpr int CW_BAR = 4096;
constexpr int CW_CNT = 8192;

constexpr int RING_BYTES = 131072;
constexpr int LDS_BYTES = 163840;
constexpr int MISC_OFF = LDS_BYTES - 512;
constexpr int TAB_OFF = LDS_BYTES - 4096;
constexpr int TAB_LCNT = TAB_OFF + 160, TAB_TINFO = TAB_OFF + 288;
constexpr int SIDE_OFF = 131072, TOK_OFF = SIDE_OFF + 8192;

#define GAS __attribute__((address_space(1)))
#define LAS __attribute__((address_space(3)))
typedef unsigned short bf16_t;
typedef short bf16x8 __attribute__((ext_vector_type(8)));
typedef float f32x4 __attribute__((ext_vector_type(4)));
typedef float f32x2 __attribute__((ext_vector_type(2)));
typedef unsigned u32x4 __attribute__((ext_vector_type(4)));
typedef unsigned u32x2 __attribute__((ext_vector_type(2)));
#define LDS_WAIT() asm volatile("s_waitcnt lgkmcnt(0)" ::: "memory")
#define VM_WAIT() asm volatile("s_waitcnt vmcnt(0)" ::: "memory")

__device__ __forceinline__ unsigned cvt_pk_bf16(float lo, float hi) { unsigned r; asm volatile("v_cvt_pk_bf16_f32 %0, %1, %2" : "=v"(r) : "v"(lo), "v"(hi)); return r; }
__device__ __forceinline__ unsigned pk_fp8x4(float a0, float a1, float a2, float a3) { int p = __builtin_amdgcn_cvt_pk_fp8_f32(a0, a1, 0, false); p = __builtin_amdgcn_cvt_pk_fp8_f32(a2, a3, p, true); return (unsigned)p; }
constexpr float MIX8_SCALE = 4.0f;
__device__ __forceinline__ unsigned pk_mix8(float a0, float a1, float a2, float a3) {
    return pk_fp8x4(__builtin_amdgcn_fmed3f(a0 * MIX8_SCALE, -448.f, 448.f), __builtin_amdgcn_fmed3f(a1 * MIX8_SCALE, -448.f, 448.f), __builtin_amdgcn_fmed3f(a2 * MIX8_SCALE, -448.f, 448.f), __builtin_amdgcn_fmed3f(a3 * MIX8_SCALE, -448.f, 448.f)); }
constexpr float Y8_SCALE = 16.0f;
constexpr float W8_SCALE = 64.0f;
__device__ __forceinline__ float bf2f(unsigned short b) { return __uint_as_float(((unsigned)b) << 16); }
__device__ __forceinline__ float bflo(unsigned w) { return __uint_as_float(w << 16); }
__device__ __forceinline__ float bfhi(unsigned w) { return __uint_as_float(w & 0xffff0000u); }
__device__ __forceinline__ float wave_sum(float v) {
#pragma unroll
    for (int o = 1; o < 64; o <<= 1) v += __shfl_xor(v, o);
    return v;
}
__device__ __forceinline__ float gelu1(float v) {
    const float av = __builtin_fabsf(v), d = av * 0.2316418882f + 1.0f;
    const float t = __builtin_amdgcn_rcpf(d);
    float q = t * 0.5307027145f + (-0.7265760135f); q = q * t + 0.7107068705f; q = q * t + (-0.142248368f); q = q * t + 0.127414796f; q = q * t;
    const float s = (v * v) * (-0.72134752044f);
    const float e = __builtin_amdgcn_exp2f(s);
    const float m = v * (q * e), r = v - m;
    return v < 0.f ? m : r;
}

namespace pg8 {
constexpr int BM = 256, BK = 64, HALF = 128, HTB = HALF * BK * 2, STAGE_BYTES = 8 * HTB, NXCD = 8, WGM = 8;
__host__ __device__ __forceinline__ int lds_byte(int r, int c) { const int st = (r >> 4) * 2 + (c >> 5), rr = r & 15, cc = c & 31, ob = rr * 64 + cc * 2; return st * 1024 + (ob ^ (((ob >> 9) & 1) << 5)); }
__host__ __device__ __forceinline__ void stage_rc(int b, int& R, int& C) { const int st = b / 1024, sb = b % 1024, swz = sb ^ (((sb >> 9) & 1) << 5); R = (st >> 1) * 16 + swz / 64; C = (st & 1) * 32 + (swz % 64) / 2; }
__host__ __device__ __forceinline__ int perm32(int rho) { const int n = rho >> 4, i = rho & 15; return 8 * (i >> 2) + 4 * n + (i & 3); }

template <int IMM> __device__ __forceinline__ void glds16_s(const void* sbase, unsigned voff, unsigned lds_base) {
    unsigned keep;
    asm volatile("s_mov_b32 %0, m0\n\ts_add_i32 m0, %3, %4\n\ts_nop 0\n\tglobal_load_lds_dwordx4 %1, %2\n\ts_mov_b32 m0, %0" : "=&s"(keep) : "v"(voff), "s"(sbase), "s"(lds_base), "i"(IMM) : "memory", "scc");
}
__device__ __forceinline__ void glds16_fresh(const void* sbase, unsigned voff, unsigned lds_dst) {
    unsigned keep;
    asm volatile("s_nop 4\n\ts_mov_b32 %0, m0\n\ts_mov_b32 m0, %3\n\ts_nop 0\n\tglobal_load_lds_dwordx4 %1, %2\n\ts_mov_b32 m0, %0" : "=&s"(keep) : "v"(voff), "s"(sbase), "s"(lds_dst) : "memory");
}
typedef int v8i __attribute__((ext_vector_type(8)));
typedef int v4i __attribute__((ext_vector_type(4)));
__device__ __forceinline__ v8i frag8(bf16x8 lo, bf16x8 hi) { return __builtin_shufflevector(__builtin_bit_cast(v4i, lo), __builtin_bit_cast(v4i, hi), 0, 1, 2, 3, 4, 5, 6, 7); }
template <class T> __device__ __forceinline__ T* uni_ptr(T* p) { const unsigned long long a = (unsigned long long)(uintptr_t)p; const unsigned lo = (unsigned)__builtin_amdgcn_readfirstlane((int)a), hi = (unsigned)__builtin_amdgcn_readfirstlane((int)(a >> 32)); return (T*)(uintptr_t)(((unsigned long long)hi << 32) | lo); }
#define GAS __attribute__((address_space(1)))
struct Unit { int pm, pn, e, mt; };

template <int EB> __device__ __forceinline__ void stage_src(int b, int& R, int& CB) {
    if constexpr (EB == 2 || !FP8_IMG) { int C; stage_rc(b, R, C); CB = C * 2; }
    else { const int f = (b >> 4) & 63; R = (b >> 10) * 8 + (f & 7); CB = (((f >> 5) & 1) * 4 + ((f >> 3) & 1) * 2 + ((f >> 4) & 1)) * 16; }
}
template <int EB> struct DenseSched {
    int nM, nN, nwg, G, c, rowb;
    __device__ void init(int M, int N, int K_, int G_, int c_) { nM = M / BM; nN = N / BM; nwg = nM * nN; G = G_; c = c_; rowb = K_ * EB; }
    __device__ __forceinline__ bool next(int i, Unit& u) const {
        const long L = (long)i * G + c; if (L >= nwg) return false;
        int wgid = (int)L; { const int q = nwg / NXCD, r = nwg % NXCD, xcd = wgid % NXCD, off = wgid / NXCD; wgid = (xcd < r ? xcd * (q + 1) : r * (q + 1) + (xcd - r) * q) + off; }
        const int nig = WGM * nN, gid = wgid / nig, fm = gid * WGM, gsz = (nM - fm) < WGM ? (nM - fm) : WGM;
        u.pm = fm + ((wgid % nig) % gsz); u.pn = (wgid % nig) / gsz; u.e = 0; u.mt = 0; return true;
    }
    __device__ __forceinline__ void a_off(const Unit& u, int tid, unsigned (&off)[2][2]) const {
#pragma unroll
        for (int i = 0; i < 2; ++i) { int R, CB; stage_src<EB>(tid * 16 + i * 8192, R, CB);
#pragma unroll
            for (int h = 0; h < 2; ++h) off[h][i] = (unsigned)((u.pm * BM + h * HALF + R) * rowb + CB); }
    }
    __device__ __forceinline__ unsigned b_off(const Unit& u) const { return (unsigned)(u.pn * BM * rowb); }
    static constexpr bool TOKSIDE = false;
    __device__ __forceinline__ const char* tok_src(const Unit&) const { return nullptr; }
    __device__ __forceinline__ void a_off_lds(const Unit&, int, unsigned (&)[2][2], const LAS int*) const {}
};
template <bool GATHER, int EB, bool ATILE = false> struct MoeSched {
    const LAS int* tinfo; const LAS int* lcnt; const int* slot_tok; int nN, rowb, nunits, G, vcu; unsigned bstride;
    __device__ __forceinline__ bool next(int i, Unit& u) const {
        const int L = i * G + vcu; if (L >= nunits) return false;
        const int T = L / nN; u.pm = T; u.pn = L - T * nN;
        const int ti = __builtin_amdgcn_readfirstlane(tinfo[T]);
        u.e = ti & 255; u.mt = ti >> 8; return true;
    }
    __device__ __forceinline__ void a_off(const Unit& u, int tid, unsigned (&off)[2][2]) const {
        const int n = GATHER ? __builtin_amdgcn_readfirstlane(lcnt[u.e]) : 0;
#pragma unroll
        for (int i = 0; i < 2; ++i) { int R, CB; stage_src<EB>(tid * 16 + i * 8192, R, CB);
#pragma unroll
            for (int h = 0; h < 2; ++h) {
                if constexpr (GATHER) { const int pos = u.mt * BM + h * HALF + R; const int row = slot_tok[u.e * CAP + (pos < n ? pos : 0)]; off[h][i] = (unsigned)((pos < n ? row : 0) * rowb + CB); }
                else off[h][i] = ATILE ? (unsigned)(u.pm * BM * rowb + (h * HALF + R) * 128 + CB) : (unsigned)((u.pm * BM + h * HALF + R) * rowb + CB); } }
    }
    __device__ __forceinline__ unsigned b_off(const Unit& u) const { return (unsigned)u.e * bstride + (unsigned)(u.pn * BM * rowb); }
    static constexpr bool TOKSIDE = GATHER && (EB == 1);
    __device__ __forceinline__ const char* tok_src(const Unit& u) const { return (const char*)(slot_tok + (size_t)u.e * CAP + (size_t)u.mt * BM); }
    __device__ __forceinline__ void a_off_lds(const Unit& u, int tid, unsigned (&off)[2][2], const LAS int* tok) const {
        const int n = __builtin_amdgcn_readfirstlane(lcnt[u.e]);
#pragma unroll
        for (int i = 0; i < 2; ++i) { int R, CB; stage_src<EB>(tid * 16 + i * 8192, R, CB);
#pragma unroll
            for (int h = 0; h < 2; ++h) { const int pos = u.mt * BM + h * HALF + R; const int row = tok[h * HALF + R]; off[h][i] = (unsigned)((pos < n ? row : 0) * rowb + CB); } }
    }
};

template <class Epi, class Sched, bool ALIGN_EPI, int SP2, int EB = 2, bool BTILED = false, bool ATILED = false>
__device__ __forceinline__ void gemm_phase(LAS unsigned char* lds, const void* Aptr, const void* Btptr, int K, const Sched& S, const Epi& E) {
    int tid = threadIdx.x; asm volatile("" : "+v"(tid));
    const int wid = __builtin_amdgcn_readfirstlane(tid >> 6), lane = tid & 63, wr = wid >> 2, wc = wid & 3, fr = lane & 15, fq = lane >> 4;
    const int rowb = K * EB, nt = rowb / 128;
    unsigned voffB[2];
#pragma unroll
    for (int i = 0; i < 2; ++i) { int R, CB; stage_src<EB>(tid * 16 + i * 8192, R, CB); voffB[i] = (unsigned)(R * (BTILED ? 128 : rowb) + CB); }
    const unsigned kstep = ATILED ? 256u * 128u : 128u;
    const unsigned hstep = (unsigned)(HALF * rowb);
    const unsigned kstepB = BTILED ? 256u * 128u : 128u, hstepB = BTILED ? (unsigned)(HALF * 128) : hstep;
    const unsigned ldsb = (unsigned)(uintptr_t)lds + (unsigned)wid * 1024u;
    const int l8 = (fr >> 3) * 1024 + (fr & 7) * 16 + (fq & 1) * 128 + (fq >> 1) * 512;
    constexpr bool IMG16 = (EB == 2) || !FP8_IMG;
    const int aoff = IMG16 ? lds_byte(wr * 64 + fr, fq * 8) : wr * 8192 + l8, boff = IMG16 ? lds_byte(wc * 32 + fr, fq * 8) : wc * 4096 + l8;
    constexpr int FSTEP = IMG16 ? 1024 : 256;
    constexpr bool SK = (EB == 1) && (SK_FP8 != 0);
    const char* Ab; const char* Bb;
    { const unsigned long long a_ = (unsigned long long)(uintptr_t)Aptr, b_ = (unsigned long long)(uintptr_t)Btptr;
      Ab = (const char*)(uintptr_t)(((unsigned long long)(unsigned)__builtin_amdgcn_readfirstlane((int)(a_ >> 32)) << 32) | (unsigned)__builtin_amdgcn_readfirstlane((int)a_));
      Bb = (const char*)(uintptr_t)(((unsigned long long)(unsigned)__builtin_amdgcn_readfirstlane((int)(b_ >> 32)) << 32) | (unsigned)__builtin_amdgcn_readfirstlane((int)b_)); }
#define PG8_SA(b, h) (((b) * 2 + (h)) * HTB)
#define PG8_SB(b, h) ((4 + (b) * 2 + (h)) * HTB)
#define PG8_STAGE_B(bufoff, sb) do { if constexpr (SK) { const char* p_ = Bb + (sb); glds16_s<(bufoff)>(p_, voffB[0], ldsb); glds16_s<(bufoff) + 8192>(p_, voffB[1], ldsb); } \
        else { glds16_s<(bufoff)>(Bb, voffB[0] + (sb), ldsb); glds16_s<(bufoff) + 8192>(Bb, voffB[1] + (sb), ldsb); } } while (0)
#define PG8_STAGE_A(bufoff, o0, o1, kb) do { if constexpr (SK) { const char* p_ = Ab + (kb); glds16_s<(bufoff)>(p_, (o0), ldsb); glds16_s<(bufoff) + 8192>(p_, (o1), ldsb); } \
        else { glds16_s<(bufoff)>(Ab, (o0) + (kb), ldsb); glds16_s<(bufoff) + 8192>(Ab, (o1) + (kb), ldsb); } } while (0)
#define PG8_LDA(dst, b, h) do { _Pragma("unroll") for (int m = 0; m < 4; ++m) _Pragma("unroll") for (int k = 0; k < 2; ++k) dst[m][k] = *(const LAS bf16x8*)(lds + PG8_SA(b, h) + aoff + m * 2048 + k * FSTEP); } while (0)
#define PG8_LDB(dst, b, h) do { _Pragma("unroll") for (int n = 0; n < 2; ++n) _Pragma("unroll") for (int k = 0; k < 2; ++k) dst[n][k] = *(const LAS bf16x8*)(lds + PG8_SB(b, h) + boff + n * 2048 + k * FSTEP); } while (0)
#define PG8_MMA(ai, bj, At, Bt) do { __builtin_amdgcn_s_setprio(1); _Pragma("unroll") for (int m = 0; m < 4; ++m) _Pragma("unroll") for (int n = 0; n < 2; ++n) { \
        if constexpr (EB == 2) { _Pragma("unroll") for (int k = 0; k < 2; ++k) acc[ai][bj][m][n] = __builtin_amdgcn_mfma_f32_16x16x32_bf16(Bt[n][k], At[m][k], acc[ai][bj][m][n], 0, 0, 0); } \
        else acc[ai][bj][m][n] = __builtin_amdgcn_mfma_scale_f32_16x16x128_f8f6f4(frag8(Bt[n][0], Bt[n][1]), frag8(At[m][0], At[m][1]), acc[ai][bj][m][n], 0, 0, 0, 0x7f7f7f7f, 0, 0x7f7f7f7f); } \
        __builtin_amdgcn_s_setprio(0); } while (0)
#define PG8_MMA_H(ai, bj, At, Bt, mh) do { _Pragma("unroll") for (int m = 2 * (mh); m < 2 * (mh) + 2; ++m) _Pragma("unroll") for (int n = 0; n < 2; ++n) { \
        if constexpr (EB == 2) { _Pragma("unroll") for (int k = 0; k < 2; ++k) acc[ai][bj][m][n] = __builtin_amdgcn_mfma_f32_16x16x32_bf16(Bt[n][k], At[m][k], acc[ai][bj][m][n], 0, 0, 0); } \
        else acc[ai][bj][m][n] = __builtin_amdgcn_mfma_scale_f32_16x16x128_f8f6f4(frag8(Bt[n][0], Bt[n][1]), frag8(At[m][0], At[m][1]), acc[ai][bj][m][n], 0, 0, 0, 0x7f7f7f7f, 0, 0x7f7f7f7f); } } while (0)
#define PG8_BLOCK(ai, D0, D1, D2) do { __builtin_amdgcn_s_setprio(1); PG8_MMA_H(ai, 0, At, B0, 0); PG8_SCHED; D0; PG8_SCHED; PG8_MMA_H(ai, 0, At, B0, 1); PG8_SCHED; D1; PG8_SCHED; \
        PG8_MMA_H(ai, 1, At, B1, 0); PG8_SCHED; D2; PG8_SCHED; PG8_MMA_H(ai, 1, At, B1, 1); __builtin_amdgcn_s_setprio(0); } while (0)
#define PG8_NOP do { } while (0)
#define PG8_NEXT_A do { if (last && has_next) { Unit n_ = nxt; int t_ = tid; asm volatile("" : "+s"(n_.pm), "+s"(n_.e), "+s"(n_.mt), "+v"(t_)); \
        if constexpr (Sched::TOKSIDE) S.a_off_lds(n_, t_, offC, (const LAS int*)(lds + TOK_OFF + ((ui + 1) & 1) * 1024)); else S.a_off(n_, t_, offC); } } while (0)
#define PG8_WAIT_V(n) asm volatile("s_waitcnt vmcnt(" #n ")" ::: "memory")
#define PG8_WAIT_L(n) asm volatile("s_waitcnt lgkmcnt(" #n ")" ::: "memory")
#define PG8_BAR __builtin_amdgcn_s_barrier()
#define PG8_SCHED __builtin_amdgcn_sched_barrier(0)
    Unit cur, nxt; int ui = 0;
    if (!S.next(0, cur)) return;
    f32x4 acc[2][2][4][2];
#pragma unroll
    for (int a = 0; a < 2; ++a)
#pragma unroll
        for (int b = 0; b < 2; ++b)
#pragma unroll
            for (int m = 0; m < 4; ++m)
#pragma unroll
                for (int n = 0; n < 2; ++n) acc[a][b][m][n] = (f32x4){0.f, 0.f, 0.f, 0.f};
    bf16x8 At[4][2], B0[2][2], B1[2][2];
    unsigned offC[2][2];
    S.a_off(cur, tid, offC);
    unsigned cB = S.b_off(cur);
    if constexpr (SP2 != 0) {
        PG8_STAGE_B(PG8_SB(0, 0), cB); PG8_STAGE_B(PG8_SB(0, 1), cB + hstepB); PG8_STAGE_A(PG8_SA(0, 0), offC[0][0], offC[0][1], 0u); PG8_STAGE_A(PG8_SA(0, 1), offC[1][0], offC[1][1], 0u);
        if (wr == 1) PG8_BAR;
        PG8_WAIT_V(2); PG8_BAR;
        PG8_STAGE_B(PG8_SB(1, 0), cB + kstepB); PG8_STAGE_A(PG8_SA(1, 0), offC[0][0], offC[0][1], kstep); PG8_STAGE_B(PG8_SB(1, 1), cB + hstepB + kstepB);
        PG8_WAIT_V(6); PG8_BAR;
    } else {
        PG8_STAGE_B(PG8_SB(0, 0), cB); PG8_STAGE_A(PG8_SA(0, 0), offC[0][0], offC[0][1], 0u); PG8_STAGE_B(PG8_SB(0, 1), cB + hstepB); PG8_STAGE_A(PG8_SA(0, 1), offC[1][0], offC[1][1], 0u);
        if (wr == 1) PG8_BAR;
        PG8_WAIT_V(4); PG8_BAR;
        PG8_STAGE_B(PG8_SB(1, 0), cB + kstepB); PG8_STAGE_A(PG8_SA(1, 0), offC[0][0], offC[0][1], kstep); PG8_STAGE_B(PG8_SB(1, 1), cB + hstepB + kstepB);
        PG8_WAIT_V(6); PG8_BAR;
    }
    for (;;) {
        const bool has_next = S.next(ui + 1, nxt);
        const unsigned nB = has_next ? S.b_off(nxt) : cB;
        if constexpr (Epi::NSIDE > 0) { if (wid < Epi::NSIDE) glds16_fresh(uni_ptr(E.side_src(cur, wid)), (unsigned)lane * 16u, (unsigned)(uintptr_t)lds + (unsigned)(SIDE_OFF + (ui & 1) * 4096) + (unsigned)wid * 1024u); }
        if constexpr (Sched::TOKSIDE) { if (wid == 4 && has_next) glds16_fresh(uni_ptr(S.tok_src(nxt)), (unsigned)lane * 16u, (unsigned)(uintptr_t)lds + (unsigned)(TOK_OFF + ((ui + 1) & 1) * 1024)); }
        for (int t = 0; t < nt; t += 2) {
            const bool last = (t == nt - 2);
            const unsigned k1 = (unsigned)(t + 1) * kstep;
            const unsigned k2 = last ? 0u : (unsigned)(t + 2) * kstep, k3 = k2 + kstep;
            const unsigned b2 = last ? nB : cB + (unsigned)(t + 2) * kstepB, b3 = b2 + kstepB;
            if constexpr (SP2 == 2) {
            PG8_LDB(B0, 0, 0); PG8_LDB(B1, 0, 1); PG8_SCHED; PG8_LDA(At, 0, 0);
            PG8_WAIT_V(6); PG8_WAIT_L(0); PG8_BAR;
            PG8_BLOCK(0, PG8_STAGE_A(PG8_SA(1, 1), offC[1][0], offC[1][1], k1), PG8_NOP, PG8_NOP); PG8_BAR; PG8_SCHED;
            PG8_LDA(At, 0, 1);
            PG8_NEXT_A;
            PG8_WAIT_V(2); PG8_WAIT_L(0); PG8_BAR;
            PG8_BLOCK(1, PG8_STAGE_B(PG8_SB(0, 0), b2), PG8_STAGE_B(PG8_SB(0, 1), b2 + hstepB), PG8_STAGE_A(PG8_SA(0, 0), offC[0][0], offC[0][1], k2)); PG8_BAR; PG8_SCHED;
            PG8_LDB(B0, 1, 0); PG8_LDB(B1, 1, 1); PG8_SCHED; PG8_LDA(At, 1, 0);
            PG8_WAIT_V(6); PG8_WAIT_L(0); PG8_BAR;
            PG8_BLOCK(0, PG8_STAGE_A(PG8_SA(0, 1), offC[1][0], offC[1][1], k2), PG8_NOP, PG8_NOP); PG8_BAR; PG8_SCHED;
            PG8_LDA(At, 1, 1);
            PG8_WAIT_V(2); PG8_WAIT_L(0); PG8_BAR;
            PG8_BLOCK(1, PG8_STAGE_B(PG8_SB(1, 0), b3), PG8_STAGE_B(PG8_SB(1, 1), b3 + hstepB), PG8_STAGE_A(PG8_SA(1, 0), offC[0][0], offC[0][1], k3)); PG8_BAR; PG8_SCHED;
            } else if constexpr (SP2 == 1) {
            PG8_LDB(B0, 0, 0); PG8_LDB(B1, 0, 1); PG8_SCHED; PG8_LDA(At, 0, 0); PG8_STAGE_A(PG8_SA(1, 1), offC[1][0], offC[1][1], k1);
            PG8_NEXT_A;
            PG8_WAIT_V(8); PG8_WAIT_L(0); PG8_BAR; PG8_MMA(0, 0, At, B0); PG8_MMA(0, 1, At, B1); PG8_BAR; PG8_SCHED;
            PG8_LDA(At, 0, 1); PG8_STAGE_B(PG8_SB(0, 0), b2); PG8_STAGE_B(PG8_SB(0, 1), b2 + hstepB); PG8_STAGE_A(PG8_SA(0, 0), offC[0][0], offC[0][1], k2);
            PG8_WAIT_V(8); PG8_WAIT_L(0); PG8_BAR; PG8_MMA(1, 0, At, B0); PG8_MMA(1, 1, At, B1); PG8_BAR; PG8_SCHED;
            PG8_LDB(B0, 1, 0); PG8_LDB(B1, 1, 1); PG8_SCHED; PG8_LDA(At, 1, 0); PG8_STAGE_A(PG8_SA(0, 1), offC[1][0], offC[1][1], k2);
            PG8_WAIT_V(8); PG8_WAIT_L(0); PG8_BAR; PG8_MMA(0, 0, At, B0); PG8_MMA(0, 1, At, B1); PG8_BAR; PG8_SCHED;
            PG8_LDA(At, 1, 1); PG8_STAGE_B(PG8_SB(1, 0), b3); PG8_STAGE_B(PG8_SB(1, 1), b3 + hstepB); PG8_STAGE_A(PG8_SA(1, 0), offC[0][0], offC[0][1], k3);
            PG8_WAIT_V(8); PG8_WAIT_L(0); PG8_BAR; PG8_MMA(1, 0, At, B0); PG8_MMA(1, 1, At, B1); PG8_BAR; PG8_SCHED;
            } else {
            PG8_LDB(B0, 0, 0); PG8_SCHED; PG8_LDA(At, 0, 0); PG8_STAGE_A(PG8_SA(1, 1), offC[1][0], offC[1][1], k1);
            PG8_NEXT_A;
            PG8_WAIT_L(8); PG8_BAR; PG8_WAIT_L(0); PG8_MMA(0, 0, At, B0); PG8_BAR; PG8_SCHED;
            PG8_LDB(B1, 0, 1); PG8_STAGE_B(PG8_SB(0, 0), b2);
            PG8_BAR; PG8_WAIT_L(0); PG8_MMA(0, 1, At, B1); PG8_BAR;
            PG8_LDA(At, 0, 1); PG8_STAGE_A(PG8_SA(0, 0), offC[0][0], offC[0][1], k2);
            PG8_BAR; PG8_WAIT_L(0); PG8_MMA(1, 0, At, B0); PG8_BAR; PG8_SCHED;
            PG8_STAGE_B(PG8_SB(0, 1), b2 + hstepB);
            PG8_WAIT_V(6); PG8_BAR; PG8_MMA(1, 1, At, B1); PG8_BAR;
            PG8_LDB(B0, 1, 0); PG8_SCHED; PG8_LDA(At, 1, 0); PG8_STAGE_A(PG8_SA(0, 1), offC[1][0], offC[1][1], k2);
            PG8_WAIT_L(8); PG8_BAR; PG8_WAIT_L(0); PG8_MMA(0, 0, At, B0); PG8_BAR; PG8_SCHED;
            PG8_LDB(B1, 1, 1); PG8_STAGE_B(PG8_SB(1, 0), b3);
            PG8_BAR; PG8_WAIT_L(0); PG8_MMA(0, 1, At, B1); PG8_BAR;
            PG8_LDA(At, 1, 1); PG8_STAGE_A(PG8_SA(1, 0), offC[0][0], offC[0][1], k3);
            PG8_BAR; PG8_WAIT_L(0); PG8_MMA(1, 0, At, B0); PG8_BAR; PG8_SCHED;
            PG8_STAGE_B(PG8_SB(1, 1), b3 + hstepB);
            PG8_WAIT_V(6); PG8_BAR; PG8_MMA(1, 1, At, B1); PG8_BAR;
            }
        }
        if constexpr (ALIGN_EPI) { if (wr == 0) PG8_BAR; }
        { Unit ue_ = cur; int fr_ = fr, fq_ = fq, wr_ = wr, wc_ = wc;
          if constexpr (EB == 1) asm volatile("" : "+s"(ue_.pm), "+s"(ue_.pn), "+s"(ue_.e), "+s"(ue_.mt), "+v"(fr_), "+v"(fq_), "+s"(wr_), "+s"(wc_));
          if constexpr (EB == 1) { Epi Ee_ = E; Ee_.opaque(); for (int er_ = 0; er_ < Epi::REP; ++er_) Ee_(acc, ue_, wr_, wc_, fr_, fq_, lds + SIDE_OFF + (ui & 1) * 4096); }
          else for (int er_ = 0; er_ < Epi::REP; ++er_) E(acc, ue_, wr_, wc_, fr_, fq_); }
        if (!has_next) break;
#pragma unroll
        for (int a = 0; a < 2; ++a)
#pragma unroll
            for (int b = 0; b < 2; ++b)
#pragma unroll
                for (int m = 0; m < 4; ++m)
#pragma unroll
                    for (int n = 0; n < 2; ++n) acc[a][b][m][n] = (f32x4){0.f, 0.f, 0.f, 0.f};
        cur = nxt; cB = nB; ++ui;
        if constexpr (ALIGN_EPI) { if (wr == 1) PG8_BAR; }
    }
    PG8_WAIT_V(0);
    if constexpr (!ALIGN_EPI) { if (wr == 0) PG8_BAR; }
    PG8_BAR;
#undef PG8_SA
#undef PG8_SB
#undef PG8_STAGE_B
#undef PG8_STAGE_A
#undef PG8_LDA
#undef PG8_LDB
#undef PG8_MMA
#undef PG8_MMA_H
#undef PG8_BLOCK
#undef PG8_NOP
#undef PG8_NEXT_A
#undef PG8_WAIT_V
#undef PG8_WAIT_L
#undef PG8_BAR
#undef PG8_SCHED
}

struct EpiWin {
    static constexpr int NSIDE = 0;
#ifndef REP_EPIWIN
#define REP_EPIWIN 1
#endif
    static constexpr int REP = REP_EPIWIN;
    bf16_t* P; bf16_t* KF; bf16_t* VF; const float* cosT; const float* sinT;
    __device__ __forceinline__ void operator()(const f32x4 (&acc)[2][2][4][2], const Unit& u, int wr, int wc, int fr, int fq) const {
        const int row0 = u.pm * BM + wr * 64 + fr, colt = u.pn * BM + wc * 64 + fq * 8;
        const int mode = (u.pn < 2) ? 0 : (u.pn == 2 ? (wc < 2 ? 1 : 4) : (u.pn <= 4 ? 3 : 2));
        const bool rope = (mode <= 1) && (u.pm < TL / BM);
#pragma unroll
        for (int ai = 0; ai < 2; ++ai)
#pragma unroll
            for (int m = 0; m < 4; ++m) {
                const int r = row0 + ai * HALF + m * 16;
                f32x4 v[2][2];
#pragma unroll
                for (int bj = 0; bj < 2; ++bj)
#pragma unroll
                    for (int n = 0; n < 2; ++n) v[bj][n] = acc[ai][bj][m][n];
                if (rope) {
                    const int t = r & (S - 1); const int idx = (fq < 2) ? (t >> 6) : 256 + (t & 63); const int tb = idx * 16 + (fq & 1) * 8;
                    f32x4 cs[2], sn[2];
                    cs[0] = *(const f32x4*)(cosT + tb); cs[1] = *(const f32x4*)(cosT + tb + 4); sn[0] = *(const f32x4*)(sinT + tb); sn[1] = *(const f32x4*)(sinT + tb + 4);
#pragma unroll
                    for (int n = 0; n < 2; ++n) { const f32x4 x1 = v[0][n], x2 = v[1][n]; v[0][n] = x1 * cs[n] - x2 * sn[n]; v[1][n] = x1 * sn[n] + x2 * cs[n]; }
                }
                if (mode == 0) {
#pragma unroll
                    for (int bj = 0; bj < 2; ++bj)
#pragma unroll
                        for (int n = 0; n < 2; ++n) v[bj][n] = v[bj][n] * QSCALE;
                }
                if (mode == 3) {
#pragma unroll
                    for (int bj = 0; bj < 2; ++bj)
#pragma unroll
                        for (int n = 0; n < 2; ++n)
#pragma unroll
                            for (int g = 0; g < 4; ++g) v[bj][n][g] = gelu1(v[bj][n][g]);
                }
                if (mode == 4) {
                    const int t32 = r & 31, ko = t32 & 15;
                    bf16_t* vb = VF + (size_t)((wc - 2) * NT32 + (r >> 5)) * 2048 + ((t32 >> 4) * 2 + ((ko >> 2) & 1)) * 256 + 4 * ((ko >> 3) & 1) + (ko & 3) + fq * 64;
#pragma unroll
                    for (int bj = 0; bj < 2; ++bj)
#pragma unroll
                        for (int n = 0; n < 2; ++n) { const unsigned w0 = cvt_pk_bf16(v[bj][n][0], v[bj][n][1]), w1 = cvt_pk_bf16(v[bj][n][2], v[bj][n][3]);
                            bf16_t* p = vb + bj * 1024 + n * 32;
                            p[0] = (bf16_t)(w0 & 0xffffu); p[8] = (bf16_t)(w0 >> 16); p[16] = (bf16_t)(w1 & 0xffffu); p[24] = (bf16_t)(w1 >> 16); }
                } else {
                    bf16_t* rowp = (mode == 1) ? KF + (size_t)(wc * NT32 + (r >> 5)) * 2048 + (r & 31) * 8 + (fq >> 1) * 512 + (fq & 1) * 256
                                               : P + (size_t)r * INC + colt;
                    const int bstep = (mode == 1) ? 1024 : 32;
#pragma unroll
                    for (int bj = 0; bj < 2; ++bj) { u32x4 w; w.x = cvt_pk_bf16(v[bj][0][0], v[bj][0][1]); w.y = cvt_pk_bf16(v[bj][0][2], v[bj][0][3]); w.z = cvt_pk_bf16(v[bj][1][0], v[bj][1][1]); w.w = cvt_pk_bf16(v[bj][1][2], v[bj][1][3]);
                        *(u32x4*)(rowp + bj * bstep) = w; }
                }
            }
    }
};
struct EpiWout {
    static constexpr int NSIDE = 0;
#ifndef REP_EPIWOUT
#define REP_EPIWOUT 1
#endif
    static constexpr int REP = REP_EPIWOUT;
    bf16_t* DX; const float* g1;
    __device__ __forceinline__ void opaque() { DX = uni_ptr(DX); g1 = uni_ptr(g1); asm volatile("" : "+s"(DX), "+s"(g1)); }
    __device__ __forceinline__ const char* side_src(const Unit&, int) const { return nullptr; }
    __device__ __forceinline__ void operator()(const f32x4 (&acc)[2][2][4][2], const Unit& u, int wr, int wc, int fr, int fq, const LAS unsigned char*) const { (*this)(acc, u, wr, wc, fr, fq); }
    __device__ __forceinline__ void operator()(const f32x4 (&acc)[2][2][4][2], const Unit& u, int wr, int wc, int fr, int fq) const {
        const int row0 = u.pm * BM + wr * 64 + fr, c0 = u.pn * BM + wc * 32 + fq * 8;
        const int midx = (u.pm < TL / BM) ? (u.pm >> 6) : 2;
        f32x4 gv[2][2];
#pragma unroll
        for (int bj = 0; bj < 2; ++bj)
#pragma unroll
            for (int n = 0; n < 2; ++n) gv[bj][n] = *(const GAS f32x4*)(g1 + midx * 6144 + c0 + bj * HALF + 4 * n) * (FP8_WOUT ? 1.0f / (W8_SCALE * MIX8_SCALE) : 1.0f);
#pragma unroll
        for (int ai = 0; ai < 2; ++ai)
#pragma unroll
            for (int m = 0; m < 4; ++m) { bf16_t* rowp = DX + (size_t)(row0 + ai * HALF + m * 16) * D + c0;
#pragma unroll
                for (int bj = 0; bj < 2; ++bj) { const f32x4 v0 = acc[ai][bj][m][0] * gv[bj][0], v1 = acc[ai][bj][m][1] * gv[bj][1];
                    u32x4 w; w.x = cvt_pk_bf16(v0[0], v0[1]); w.y = cvt_pk_bf16(v0[2], v0[3]); w.z = cvt_pk_bf16(v1[0], v1[1]); w.w = cvt_pk_bf16(v1[2], v1[3]);
                    *(GAS u32x4*)(rowp + bj * HALF) = w; } }
    }
};
struct EpiMoe1 {
#ifndef REP_EPIMOE1
#define REP_EPIMOE1 1
#endif
    static constexpr int REP = REP_EPIMOE1;
    bf16_t* ACT; const float* b1;
    __device__ __forceinline__ void opaque() { ACT = uni_ptr(ACT); b1 = uni_ptr(b1); asm volatile("" : "+s"(ACT), "+s"(b1)); }
    static constexpr int NSIDE = 1;
    __device__ __forceinline__ const char* side_src(const Unit& u, int) const { return (const char*)(b1 + (size_t)u.e * FF2 + (size_t)u.pn * 256); }
    __device__ __forceinline__ void operator()(const f32x4 (&acc)[2][2][4][2], const Unit& u, int wr, int wc, int fr, int fq, const LAS unsigned char* side) const {
        const int row0 = u.pm * BM + wr * 64 + fr, f0 = u.pn * 128 + wc * 32 + fq * 8;
        f32x4 bb[4];
#pragma unroll
        for (int q = 0; q < 4; ++q) bb[q] = *(const LAS f32x4*)(side + (2 * (wc * 32 + fq * 8) + 4 * q) * 4);
#pragma unroll
        for (int ai = 0; ai < 2; ++ai)
#pragma unroll
            for (int m = 0; m < 4; ++m) { float a[8];
#pragma unroll
                for (int n = 0; n < 2; ++n)
#pragma unroll
                    for (int g = 0; g < 4; ++g) {
                        const float bg = bb[2 * n + (g >> 1)][2 * (g & 1)], bl = bb[2 * n + (g >> 1)][2 * (g & 1) + 1];
                        constexpr float WS1 = FP8_MOE1 ? 1.0f / W8_SCALE : 1.0f;
                        const float gg = __builtin_fminf(acc[ai][0][m][n][g] * WS1 + bg, 7.0f);
                        const float ll = __builtin_fminf(__builtin_fmaxf(acc[ai][1][m][n][g] * WS1 + bl, -7.0f), 7.0f);
                        const float sg = __builtin_amdgcn_rcpf(1.0f + __builtin_amdgcn_exp2f(gg * (-1.702f * LOG2E)));
                        a[4 * n + g] = gg * sg * (ll + 1.0f);
                    }
                if constexpr (FP8_MOE2) { u32x2 w; w.x = pk_fp8x4(a[0], a[1], a[2], a[3]); w.y = pk_fp8x4(a[4], a[5], a[6], a[7]);
                    *(GAS u32x2*)((unsigned char*)ACT + (size_t)u.pm * BM * FF + (size_t)u.pn * 32768 + (size_t)(wr * 64 + fr + ai * HALF + m * 16) * 128 + (f0 - u.pn * 128)) = w; }
                else { u32x4 w; w.x = cvt_pk_bf16(a[0], a[1]); w.y = cvt_pk_bf16(a[2], a[3]); w.z = cvt_pk_bf16(a[4], a[5]); w.w = cvt_pk_bf16(a[6], a[7]);
                    *(GAS u32x4*)(ACT + (size_t)(row0 + ai * HALF + m * 16) * FF + f0) = w; } }
    }
};
struct EpiMoe2 {
#ifndef REP_EPIMOE2
#define REP_EPIMOE2 1
#endif
    static constexpr int REP = REP_EPIMOE2;
    bf16_t* Y; const float* b2; const int* slot_asg; const float* slot_gate; const LAS int* lcnt;
    __device__ __forceinline__ void opaque() { Y = uni_ptr(Y); b2 = uni_ptr(b2); slot_asg = uni_ptr(slot_asg); slot_gate = uni_ptr(slot_gate); unsigned lc_ = (unsigned)__builtin_amdgcn_readfirstlane((int)(unsigned)(uintptr_t)lcnt);
        asm volatile("" : "+s"(Y), "+s"(b2), "+s"(slot_asg), "+s"(slot_gate), "+s"(lc_)); lcnt = (const LAS int*)(uintptr_t)lc_; }
    static constexpr int NSIDE = 3;
    __device__ __forceinline__ const char* side_src(const Unit& u, int j) const {
        return j == 0 ? (const char*)(b2 + (size_t)u.e * D + (size_t)u.pn * BM) : j == 1 ? (const char*)(slot_asg + (size_t)u.e * CAP + (size_t)u.mt * BM) : (const char*)(slot_gate + (size_t)u.e * CAP + (size_t)u.mt * BM); }
    __device__ __forceinline__ void operator()(const f32x4 (&acc)[2][2][4][2], const Unit& u, int wr, int wc, int fr, int fq, const LAS unsigned char* side) const {
        const int c0 = u.pn * BM + wc * 32 + fq * 8; const int n_e = __builtin_amdgcn_readfirstlane(lcnt[u.e]);
        f32x4 bv[2][2];
#pragma unroll
        for (int bj = 0; bj < 2; ++bj)
#pragma unroll
            for (int n = 0; n < 2; ++n) bv[bj][n] = *(const LAS f32x4*)(side + (wc * 32 + fq * 8 + bj * HALF + 4 * n) * 4);
        int asg[2][4]; float gtv[2][4];
#pragma unroll
        for (int ai = 0; ai < 2; ++ai)
#pragma unroll
            for (int m = 0; m < 4; ++m) { const int pl = ai * HALF + wr * 64 + m * 16 + fr; asg[ai][m] = *(const LAS int*)(side + 1024 + pl * 4); gtv[ai][m] = *(const LAS float*)(side + 2048 + pl * 4); }
#pragma unroll
        for (int ai = 0; ai < 2; ++ai)
#pragma unroll
            for (int m = 0; m < 4; ++m) { const int pos = u.mt * BM + ai * HALF + wr * 64 + m * 16 + fr;
                if (pos < n_e) {
                    unsigned char* rowp = (unsigned char*)Y + (size_t)asg[ai][m] * D + c0;
                    const float gs = gtv[ai][m] * Y8_SCALE;
#pragma unroll
                    for (int bj = 0; bj < 2; ++bj) { constexpr float WS2 = FP8_MOE2 ? 1.0f / W8_SCALE : 1.0f;
                        const f32x4 v0 = (acc[ai][bj][m][0] * WS2 + bv[bj][0]) * gs, v1 = (acc[ai][bj][m][1] * WS2 + bv[bj][1]) * gs;
                        u32x2 w; w.x = pk_fp8x4(v0[0], v0[1], v0[2], v0[3]); w.y = pk_fp8x4(v1[0], v1[1], v1[2], v1[3]);
                        *(GAS u32x2*)(rowp + bj * HALF) = w; } } }
    }
};
}

#define XB_TMO      128
#define XB_XCNT(j)  (256  + 64 * (j))
#define XB_XSUB(j)  (1280 + 64 * (j))
#define XB_XGEN(j)  (2304 + 64 * (j))
#define XB_TOP      3328
#define XB_TOPGEN   3392
#define XCD_BAR_WORDS 3456
#define XB_SPIN_CAP (1u << 18)
__device__ __forceinline__ unsigned xb_ld(unsigned* p)              { return __hip_atomic_load(p, __ATOMIC_RELAXED, __HIP_MEMORY_SCOPE_AGENT); }
__device__ __forceinline__ unsigned xb_add(unsigned* p, unsigned v) { return __hip_atomic_fetch_add(p, v, __ATOMIC_RELAXED, __HIP_MEMORY_SCOPE_AGENT); }
__device__ __forceinline__ unsigned xb_xcc_id() { return (unsigned)__builtin_amdgcn_s_getreg((3 << 11) | 20) & 0xFu; }
#define XB_SPIN(cond, bar) do { unsigned _sp = 0; while (cond) { __builtin_amdgcn_s_sleep(1); \
    if ((++_sp & 255u) == 0u) { if (xb_ld(&(bar)[XB_TMO])) break; if (_sp > XB_SPIN_CAP) { atomicAdd(&(bar)[XB_TMO], 1u); break; } } } } while (0)
struct XcdBarrier { unsigned* bar; unsigned x; volatile LAS unsigned* st; };
__device__ __forceinline__ XcdBarrier xcd_barrier_post(unsigned* bar, volatile LAS unsigned* st) {
    XcdBarrier b; b.bar = bar; b.x = xb_xcc_id(); b.st = st;
    if (threadIdx.x == 0) (void)xb_add(&bar[XB_XCNT(b.x)], 1u);
    return b;
}
__device__ __forceinline__ void xcd_barrier_complete(unsigned* bar, unsigned x, unsigned& nloc, unsigned& nx) {
    const unsigned G = gridDim.x * gridDim.y * gridDim.z;
    unsigned sum, cnt, mine, sp = 0u;
    for (;;) {
        sum = 0u; cnt = 0u; mine = 0u;
#pragma unroll
        for (unsigned j = 0; j < 16; ++j) { const unsigned c = xb_ld(&bar[XB_XCNT(j)]); sum += c; cnt += (c > 0u) ? 1u : 0u; mine = (j == x) ? c : mine; }
        if (sum == G) break;
        __builtin_amdgcn_s_sleep(1);
        if ((++sp & 255u) == 0u) { if (xb_ld(&bar[XB_TMO])) break; if (sp > XB_SPIN_CAP) { atomicAdd(&bar[XB_TMO], 1u); break; } }
    }
    nloc = mine > 0u ? mine : 1u; nx = cnt > 0u ? cnt : 1u;
}
__device__ __forceinline__ void xcd_barrier(const XcdBarrier& b) {
    asm volatile("s_waitcnt vmcnt(0)" ::: "memory");
    __syncthreads();
    if (threadIdx.x == 0) {
        unsigned* bar = b.bar;
        __builtin_amdgcn_s_waitcnt(0);
        unsigned nloc = b.st[0], nx = b.st[1];
        if (nloc == 0u) { xcd_barrier_complete(bar, b.x, nloc, nx); b.st[0] = nloc; b.st[1] = nx; }
        const unsigned old = xb_add(&bar[XB_XSUB(b.x)], 1u);
        const unsigned gen = old / nloc;
        if (old + 1u == (gen + 1u) * nloc) {
            __builtin_amdgcn_fence(__ATOMIC_RELEASE, "agent");
            asm volatile("s_waitcnt vmcnt(0)" ::: "memory");
            const unsigned og = xb_add(&bar[XB_TOP], 1u);
            const unsigned tg = og / nx;
            if (og + 1u == (tg + 1u) * nx) xb_add(&bar[XB_TOPGEN], 1u);
            else XB_SPIN(xb_ld(&bar[XB_TOPGEN]) == tg, bar);
            __builtin_amdgcn_fence(__ATOMIC_ACQUIRE, "agent");
            xb_add(&bar[XB_XGEN(b.x)], 1u);
            asm volatile("s_waitcnt vmcnt(0)" ::: "memory");
        } else {
            XB_SPIN(xb_ld(&bar[XB_XGEN(b.x)]) == gen, bar);
            __builtin_amdgcn_fence(__ATOMIC_ACQUIRE, "agent");
            asm volatile("s_waitcnt vmcnt(0)" ::: "memory");
        }
    }
    __syncthreads();
}

struct Args { const float* in[25]; float* out; unsigned char* ws; int ph_lo, ph_hi; };
struct Frame {
    LAS unsigned char* lds; volatile LAS unsigned* MISC; unsigned* ctl;
    int tid, lane, wave, vcu, G, bx;
    const __attribute__((address_space(4))) Args* ka; float* out; unsigned char* ws;
};
enum { I_X = 0, I_C, I_CTX, I_CCTX, I_N1G, I_N2G, I_ADAW, I_ADAB, I_WIN, I_SINK, I_SGUWS, I_SGUB, I_SGULNG, I_SGULNB, I_POOLW, I_POOLS, I_CONVW, I_WOUT, I_RW, I_RB, I_W1, I_B1, I_W2, I_B2, I_FG };

__device__ __forceinline__ void conv_item(const float* W, int ldw, int colbase, int cstride, bf16_t* Bt, int K, int prow0, int k0, bool perm, LAS float* scr, int lane) {
    { float t_[32]; const float* wp_ = W + (size_t)(k0 + (lane >> 5)) * ldw + colbase + (lane & 31) * cstride;
#pragma unroll
      for (int i = 0; i < 32; ++i) t_[i] = wp_[(size_t)(2 * i) * ldw];
#pragma unroll
      for (int i = 0; i < 32; ++i) scr[(2 * i + (lane >> 5)) * 33 + (lane & 31)] = t_[i]; }
    LDS_WAIT(); asm volatile("" ::: "memory");
    const int c = lane & 7;
#pragma unroll
    for (int j = 0; j < 4; ++j) { const int n = (lane >> 3) + 8 * j; const int o = perm ? pg8::perm32(n) : n; const LAS float* s = scr + (8 * c) * 33 + o;
        u32x4 w; w.x = cvt_pk_bf16(s[0 * 33], s[1 * 33]); w.y = cvt_pk_bf16(s[2 * 33], s[3 * 33]); w.z = cvt_pk_bf16(s[4 * 33], s[5 * 33]); w.w = cvt_pk_bf16(s[6 * 33], s[7 * 33]);
        *(u32x4*)(Bt + (size_t)(prow0 + n) * K + k0 + 8 * c) = w; }
    LDS_WAIT(); asm volatile("" ::: "memory");
}
__device__ __forceinline__ void conv_item8(const float* W, int ldw, int colbase, int cstride, unsigned char* Bt, int K, int prow0, int k0, bool perm, LAS float* scr, int lane) {
    { float t_[32]; const float* wp_ = W + (size_t)(k0 + (lane >> 5)) * ldw + colbase + (lane & 31) * cstride;
#pragma unroll
      for (int i = 0; i < 32; ++i) t_[i] = wp_[(size_t)(2 * i) * ldw];
#pragma unroll
      for (int i = 0; i < 32; ++i) scr[(2 * i + (lane >> 5)) * 33 + (lane & 31)] = t_[i]; }
    LDS_WAIT(); asm volatile("" ::: "memory");
    const int c = lane & 7;
#pragma unroll
    for (int j = 0; j < 4; ++j) { const int n = (lane >> 3) + 8 * j; const int o = perm ? pg8::perm32(n) : n; const LAS float* s = scr + (8 * c) * 33 + o;
        u32x2 w; w.x = pk_fp8x4(s[0 * 33] * W8_SCALE, s[1 * 33] * W8_SCALE, s[2 * 33] * W8_SCALE, s[3 * 33] * W8_SCALE); w.y = pk_fp8x4(s[4 * 33] * W8_SCALE, s[5 * 33] * W8_SCALE, s[6 * 33] * W8_SCALE, s[7 * 33] * W8_SCALE);
        { const int p_ = prow0 + n, k_ = k0 + 8 * c; *(u32x2*)(Bt + (size_t)(p_ >> 8) * 256 * K + (size_t)(k_ >> 7) * 32768 + (p_ & 255) * 128 + (k_ & 127)) = w; } }
    LDS_WAIT(); asm volatile("" ::: "memory");
}
__device__ __forceinline__ void conv_item8_pair(const float* W, int ldw, int colbase, unsigned char* Bt, int K, int prow0, int k0, LAS float* scr, int lane) {
    { f32x2 t_[32]; const float* wp_ = W + (size_t)(k0 + (lane >> 5)) * ldw + colbase + (lane & 31) * 2;
#pragma unroll
      for (int i = 0; i < 32; ++i) t_[i] = *(const f32x2*)(wp_ + (size_t)(2 * i) * ldw);
#pragma unroll
      for (int i = 0; i < 32; ++i) { scr[(2 * i + (lane >> 5)) * 33 + (lane & 31)] = t_[i].x; scr[64 * 33 + (2 * i + (lane >> 5)) * 33 + (lane & 31)] = t_[i].y; } }
    LDS_WAIT(); asm volatile("" ::: "memory");
    const int c = lane & 7;
#pragma unroll
    for (int bj = 0; bj < 2; ++bj)
#pragma unroll
        for (int j = 0; j < 4; ++j) { const int n = (lane >> 3) + 8 * j; const int o = pg8::perm32(n); const LAS float* s = scr + bj * 64 * 33 + (8 * c) * 33 + o;
            u32x2 w; w.x = pk_fp8x4(s[0 * 33] * W8_SCALE, s[1 * 33] * W8_SCALE, s[2 * 33] * W8_SCALE, s[3 * 33] * W8_SCALE); w.y = pk_fp8x4(s[4 * 33] * W8_SCALE, s[5 * 33] * W8_SCALE, s[6 * 33] * W8_SCALE, s[7 * 33] * W8_SCALE);
            { const int p_ = prow0 + bj * 128 + n, k_ = k0 + 8 * c; *(u32x2*)(Bt + (size_t)(p_ >> 8) * 256 * K + (size_t)(k_ >> 7) * 32768 + (p_ & 255) * 128 + (k_ & 127)) = w; } }
    LDS_WAIT(); asm volatile("" ::: "memory");
}
__device__ __forceinline__ void p0_prologue(Frame& F) {
    LAS float* scr = (LAS float*)(F.lds + F.wave * 17408);
    const int gw = F.vcu * 8 + F.wave, NGW = F.G * 8;
    constexpr int IT_WIN = (INC / 32) * (D / 64);
    constexpr int IT_WOUT = (D / 32) * (MIXW / 64);
    constexpr int IT_W1 = FP8_MOE1 ? (FF / 32) * (D / 64) : (FF2 / 32) * (D / 64);
    constexpr int IT_W2 = (D / 32) * (FF / 64);
    constexpr int N_WIN = DEPTH * IT_WIN, N_WOUT = DEPTH * IT_WOUT, N_W1 = DEPTH * NE * IT_W1, N_W2 = DEPTH * NE * IT_W2;
    constexpr int NITEMS = N_WIN + N_WOUT;
    (void)N_W1; (void)N_W2;
    for (int it = gw; it < NITEMS; it += NGW) {
        int r = it;
        if (r < N_WIN) { const int l = r / IT_WIN; r -= l * IT_WIN; const int g = r / (D / 64), kb = r % (D / 64); const int pn = g >> 3, gi = g & 7, bj = gi >> 2, wc = gi & 3;
            conv_item(F.ka->in[I_WIN] + (size_t)l * D * INC, INC, pn * 256 + wc * 64 + bj * 32, 1, (bf16_t*)(F.ws + WS_WIN) + (size_t)l * INC * D, D, g * 32, kb * 64, true, scr, F.lane); continue; }
        r -= N_WIN;
        if (r < N_WOUT) { const int l = r / IT_WOUT; r -= l * IT_WOUT; const int g = r / (MIXW / 64), kb = r % (MIXW / 64);
            if (FP8_WOUT) conv_item8(F.ka->in[I_WOUT] + (size_t)l * MIXW * D, D, g * 32, 1, F.ws + WS_WOUT + (size_t)l * D * MIXW, MIXW, g * 32, kb * 64, true, scr, F.lane);
            else conv_item(F.ka->in[I_WOUT] + (size_t)l * MIXW * D, D, g * 32, 1, (bf16_t*)(F.ws + WS_WOUT) + (size_t)l * D * MIXW, MIXW, g * 32, kb * 64, true, scr, F.lane);
            continue; }
    }
    __syncthreads();
    {
        LAS float* part = (LAS float*)F.lds;
        float* mod = (float*)(F.ws + WS_MOD);
        for (int task = F.vcu; task < DEPTH * 96; task += F.G) {
            const int l = task / 96, n0 = (task % 96) * 64;
            const float* aw = F.ka->in[I_ADAW] + (size_t)l * D * 6144 + n0 + F.lane;
            float a0 = 0.f, a1 = 0.f, a2 = 0.f;
            float sl[3][2];
#pragma unroll
            for (int hh = 0; hh < 2; ++hh) { const int k = F.wave * 128 + hh * 64 + F.lane; const float c0 = F.ka->in[I_C][k], c1 = F.ka->in[I_C][D + k], c2 = F.ka->in[I_CCTX][k];
                sl[0][hh] = c0 / (1.f + __expf(-c0)); sl[1][hh] = c1 / (1.f + __expf(-c1)); sl[2][hh] = c2 / (1.f + __expf(-c2)); }
#pragma unroll
            for (int hh = 0; hh < 2; ++hh)
                for (int kb = 0; kb < 64; kb += 32) { float w[32];
#pragma unroll
                    for (int u = 0; u < 32; ++u) w[u] = aw[(size_t)(F.wave * 128 + hh * 64 + kb + u) * 6144];
#pragma unroll
                    for (int u = 0; u < 32; ++u) { const int kk = kb + u;
                        a0 += w[u] * __builtin_bit_cast(float, __builtin_amdgcn_readlane(__builtin_bit_cast(int, sl[0][hh]), kk));
                        a1 += w[u] * __builtin_bit_cast(float, __builtin_amdgcn_readlane(__builtin_bit_cast(int, sl[1][hh]), kk));
                        a2 += w[u] * __builtin_bit_cast(float, __builtin_amdgcn_readlane(__builtin_bit_cast(int, sl[2][hh]), kk)); } }
            part[(F.wave * 3 + 0) * 64 + F.lane] = a0; part[(F.wave * 3 + 1) * 64 + F.lane] = a1; part[(F.wave * 3 + 2) * 64 + F.lane] = a2;
            __syncthreads();
            if (F.tid < 192) { const int j = F.tid >> 6, n = F.tid & 63; float s = 0.f;
#pragma unroll
                for (int w = 0; w < 8; ++w) s += part[(w * 3 + j) * 64 + n];
                mod[(size_t)(l * 3 + j) * 6144 + n0 + n] = s + F.ka->in[I_ADAB][l * 6144 + n0 + n]; }
            __syncthreads();
        }
    }
    {
        bf16_t* sw = (bf16_t*)(F.ws + WS_SGUW); const float* src = F.ka->in[I_SGUWS];
        for (int i = F.vcu * 512 + F.tid; i < DEPTH * 4 * 128 * 128 / 2; i += F.G * 512) ((unsigned*)sw)[i] = cvt_pk_bf16(src[2 * i], src[2 * i + 1]);
        bf16_t* pt = (bf16_t*)(F.ws + WS_POOLWT); const float* ps = F.ka->in[I_POOLW];
        for (int i = F.vcu * 512 + F.tid; i < DEPTH * 4 * 64 * 64; i += F.G * 512) { const int lg = i >> 12, d = (i >> 6) & 63, c = i & 63; pt[i] = (bf16_t)(cvt_pk_bf16(ps[(size_t)lg * 4096 + c * 64 + d], 0.f) & 0xffffu); }
    }
    {
        float* cosT = (float*)(F.ws + WS_ROPE); float* sinT = cosT + 320 * 16;
        for (int i = F.tid * F.G + F.vcu; i < 320 * 16; i += F.G * 512) { const int p = i >> 4, d = i & 15; const int pos = p < 256 ? p : p - 256;
            const float inv = (float)exp2(-(double)d * (13.287712379549449 / 16.0));
            const float ang = (float)pos * inv;
            cosT[i] = cosf(ang); sinT[i] = sinf(ang); }
    }
}

__device__ __forceinline__ void p_convert_w1(Frame& F, int l) {
    __syncthreads();
    LAS float* scr = (LAS float*)(F.lds + F.wave * 17408);
    const int gw = F.vcu * 8 + F.wave, NGW = F.G * 8;
    constexpr int IT_W1 = FP8_MOE1 ? (FF / 32) * (D / 64) : (FF2 / 32) * (D / 64);
    for (int it = gw; it < NE * IT_W1; it += NGW) {
        int r = it; const int le = l * NE + r / IT_W1; r -= (r / IT_W1) * IT_W1; const int g = r / (D / 64), kb = r % (D / 64); const int pn = g >> 3, gi = g & 7, bj = gi >> 2, wc = gi & 3;
        if (FP8_MOE1) { const int pn8 = g >> 2, wc8 = g & 3;
            conv_item8_pair(F.ka->in[I_W1] + (size_t)le * D * FF2, FF2, 2 * (pn8 * 128 + wc8 * 32), F.ws + WS_W1 + (size_t)le * FF2 * D, D, pn8 * 256 + wc8 * 32, kb * 64, scr, F.lane); }
        else conv_item(F.ka->in[I_W1] + (size_t)le * D * FF2, FF2, 2 * (pn * 128 + wc * 32) + bj, 2, (bf16_t*)(F.ws + WS_W1) + (size_t)le * FF2 * D, D, g * 32, kb * 64, true, scr, F.lane);
    }
    __syncthreads();
}
__device__ __forceinline__ void p_convert_w2(Frame& F, int l) {
    __syncthreads();
    LAS float* scr = (LAS float*)(F.lds + F.wave * 17408);
    const int gw = F.vcu * 8 + F.wave, NGW = F.G * 8;
    constexpr int IT_W2 = (D / 32) * (FF / 64);
    for (int it = gw; it < NE * IT_W2; it += NGW) {
        int r = it; const int le = l * NE + r / IT_W2; r -= (r / IT_W2) * IT_W2; const int g = r / (FF / 64), kb = r % (FF / 64);
        if (FP8_MOE2) conv_item8(F.ka->in[I_W2] + (size_t)le * FF * D, D, g * 32, 1, F.ws + WS_W2 + (size_t)le * D * FF, FF, g * 32, kb * 64, true, scr, F.lane);
        else conv_item(F.ka->in[I_W2] + (size_t)le * FF * D, D, g * 32, 1, (bf16_t*)(F.ws + WS_W2) + (size_t)le * D * FF, FF, g * 32, kb * 64, true, scr, F.lane);
    }
    __syncthreads();
}

__device__ __forceinline__ const float* xrow_in(const Frame& F, int layer, int r) {
    if (layer == 0) return r < TL ? F.ka->in[I_X] + (size_t)r * D : F.ka->in[I_CTX] + (size_t)(r - TL) * D;
    return (const float*)(F.ws + WS_XL) + (size_t)r * D;
}
__device__ __forceinline__ int mod_index(int r) { return r < TL ? (r >> 14) : 2; }

__device__ __forceinline__ void norm_mod_store(const f32x4 (&v)[4], const float* g, const float* shift, const float* scale, bf16_t* hrow, int lane) {
    float ss = 0.f;
#pragma unroll
    for (int j = 0; j < 4; ++j) ss += (v[j].x * v[j].x + v[j].y * v[j].y) + (v[j].z * v[j].z + v[j].w * v[j].w);
    const float rstd = 1.0f / sqrtf(wave_sum(ss) * (1.f / D) + EPS);
#pragma unroll
    for (int j = 0; j < 4; ++j) { const int c = 4 * lane + 256 * j;
        const f32x4 gg = *(const f32x4*)(g + c), sh = *(const f32x4*)(shift + c), sc = *(const f32x4*)(scale + c);
        const f32x4 y = (v[j] * rstd * gg) * (sc + 1.0f) + sh;
        u32x2 w; w.x = cvt_pk_bf16(y.x, y.y); w.y = cvt_pk_bf16(y.z, y.w);
        *(u32x2*)(hrow + c) = w; }
}
__device__ __forceinline__ void p_norm1_first(Frame& F) {
    const int gw = F.vcu * 8 + F.wave, NGW = F.G * 8;
    const float* mod = (const float*)(F.ws + WS_MOD);
    bf16_t* H = (bf16_t*)(F.ws + WS_H);
    for (int r = gw; r < MT; r += NGW) {
        const float* x = xrow_in(F, 0, r); const int mi = mod_index(r);
        f32x4 v[4];
#pragma unroll
        for (int j = 0; j < 4; ++j) v[j] = *(const f32x4*)(x + 4 * F.lane + 256 * j);
        norm_mod_store(v, F.ka->in[I_N1G], mod + (size_t)mi * 6144, mod + (size_t)mi * 6144 + D, H + (size_t)r * D, F.lane);
    }
}

typedef float f32x16 __attribute__((ext_vector_type(16)));
#define MFMA32(a, b, c) __builtin_amdgcn_mfma_f32_32x32x16_bf16(a, b, c, 0, 0, 0)
__device__ __forceinline__ int crow(int g, int hi) { return (g & 3) + 8 * (g >> 2) + 4 * hi; }

__device__ __forceinline__ void attn_task(Frame& F, int layer, int g32, int hq) {
    const int lane = F.lane, r32 = lane & 31, hi = lane >> 5, kvh = hq >> 2;
    const bf16_t* P = (const bf16_t*)(F.ws + WS_P); bf16_t* MIX = (bf16_t*)(F.ws + WS_MIX);
    const bf16_t* KFh = (const bf16_t*)(F.ws + WS_KF) + (size_t)kvh * NT32 * 2048 + lane * 8;
    const bf16_t* VFh = (const bf16_t*)(F.ws + WS_VF) + (size_t)kvh * NT32 * 2048 + lane * 8;
    const int qrow = 32 * g32 + r32;
    bf16x8 qf[4];
#pragma unroll
    for (int d0 = 0; d0 < 4; ++d0) qf[d0] = *(const bf16x8*)(P + (size_t)qrow * INC + PC_Q + hq * 64 + 16 * d0 + 8 * hi);
    int tb0, tb1, tc0;
    if (g32 < TL / 32) { const int b = g32 >> 9, s0 = b * 512; tb0 = g32 - 4 < s0 ? s0 : g32 - 4; tb1 = g32 + 5 > s0 + 512 ? s0 + 512 : g32 + 5; tc0 = TL / 32 + b * 8; }
    else { const int b = (g32 - TL / 32) >> 3; tb0 = 0; tb1 = 0; tc0 = TL / 32 + b * 8; }
    const int nb = tb1 - tb0, nt = nb + 8;
    float m = F.ka->in[I_SINK][layer * 8 + hq] * LOG2E, lsum = hi == 0 ? 1.0f : 0.0f;
    f32x16 o0, o1;
#pragma unroll
    for (int g = 0; g < 16; ++g) { o0[g] = 0.f; o1[g] = 0.f; }
    bf16x8 k0[4], v0[4], k1[4], v1[4], k2[4], v2[4];
#define AT_TILE(i) ((i) < nb ? tb0 + (i) : tc0 + ((i) - nb))
#define AT_LOAD(KF, VF, i) do { const size_t to_ = (size_t)AT_TILE(i) * 2048; _Pragma("unroll") for (int j = 0; j < 4; ++j) { KF[j] = *(const bf16x8*)(KFh + to_ + j * 512); VF[j] = *(const bf16x8*)(VFh + to_ + j * 512); } } while (0)
#define AT_COMPUTE(KF, VF, i) do { const int tt = AT_TILE(i); \
        f32x16 sc; _Pragma("unroll") for (int g = 0; g < 16; ++g) sc[g] = 0.f; \
        _Pragma("unroll") for (int d0 = 0; d0 < 4; ++d0) sc = MFMA32(KF[d0], qf[d0], sc); \
        if ((i) < nb) { \
            if (tt == g32 - 4) { _Pragma("unroll") for (int g = 0; g < 16; ++g) sc[g] = (crow(g, hi) >= r32) ? sc[g] : -INFINITY; } \
            if (tt == g32 + 4) { _Pragma("unroll") for (int g = 0; g < 16; ++g) sc[g] = (crow(g, hi) <= r32) ? sc[g] : -INFINITY; } } \
        float tm = sc[0]; _Pragma("unroll") for (int g = 1; g < 16; ++g) tm = __builtin_fmaxf(tm, sc[g]); \
        tm = __builtin_fmaxf(tm, __shfl_xor(tm, 32)); \
        const float mn = __builtin_fmaxf(m, tm); \
        if (__any(mn > m)) { const float al = __builtin_amdgcn_exp2f(m - mn); lsum *= al; _Pragma("unroll") for (int g = 0; g < 16; ++g) { o0[g] *= al; o1[g] *= al; } } \
        m = mn; float ps = 0.f; \
        _Pragma("unroll") for (int g = 0; g < 16; ++g) { sc[g] = __builtin_amdgcn_exp2f(sc[g] - m); ps += sc[g]; } \
        lsum += ps; \
        u32x4 p0, p1; \
        p0.x = cvt_pk_bf16(sc[0], sc[1]); p0.y = cvt_pk_bf16(sc[2], sc[3]); p0.z = cvt_pk_bf16(sc[4], sc[5]); p0.w = cvt_pk_bf16(sc[6], sc[7]); \
        p1.x = cvt_pk_bf16(sc[8], sc[9]); p1.y = cvt_pk_bf16(sc[10], sc[11]); p1.z = cvt_pk_bf16(sc[12], sc[13]); p1.w = cvt_pk_bf16(sc[14], sc[15]); \
        o0 = MFMA32(VF[0], __builtin_bit_cast(bf16x8, p0), o0); o0 = MFMA32(VF[1], __builtin_bit_cast(bf16x8, p1), o0); \
        o1 = MFMA32(VF[2], __builtin_bit_cast(bf16x8, p0), o1); o1 = MFMA32(VF[3], __builtin_bit_cast(bf16x8, p1), o1); } while (0)
    AT_LOAD(k0, v0, 0); AT_LOAD(k1, v1, 1);
    for (int i = 0; i < nt; i += 3) {
        if (i + 2 < nt) AT_LOAD(k2, v2, i + 2);
        AT_COMPUTE(k0, v0, i);
        if (i + 1 < nt) { if (i + 3 < nt) AT_LOAD(k0, v0, i + 3); AT_COMPUTE(k1, v1, i + 1); }
        if (i + 2 < nt) { if (i + 4 < nt) AT_LOAD(k1, v1, i + 4); AT_COMPUTE(k2, v2, i + 2); }
    }
#undef AT_TILE
#undef AT_LOAD
#undef AT_COMPUTE
    const float rl = 1.0f / (lsum + __shfl_xor(lsum, 32));
    if (FP8_WOUT) { unsigned char* orow8 = (unsigned char*)MIX + (size_t)qrow * MIXW + hq * 64 + 4 * hi;
#pragma unroll
        for (int i4 = 0; i4 < 4; ++i4) { *(unsigned*)(orow8 + 8 * i4) = pk_mix8(o0[4 * i4] * rl, o0[4 * i4 + 1] * rl, o0[4 * i4 + 2] * rl, o0[4 * i4 + 3] * rl);
            *(unsigned*)(orow8 + 32 + 8 * i4) = pk_mix8(o1[4 * i4] * rl, o1[4 * i4 + 1] * rl, o1[4 * i4 + 2] * rl, o1[4 * i4 + 3] * rl); }
        return; }
    bf16_t* orow = MIX + (size_t)qrow * MIXW + hq * 64 + 4 * hi;
#pragma unroll
    for (int i4 = 0; i4 < 4; ++i4) {
        u32x2 w; w.x = cvt_pk_bf16(o0[4 * i4] * rl, o0[4 * i4 + 1] * rl); w.y = cvt_pk_bf16(o0[4 * i4 + 2] * rl, o0[4 * i4 + 3] * rl); *(u32x2*)(orow + 8 * i4) = w;
        u32x2 x; x.x = cvt_pk_bf16(o1[4 * i4] * rl, o1[4 * i4 + 1] * rl); x.y = cvt_pk_bf16(o1[4 * i4 + 2] * rl, o1[4 * i4 + 3] * rl); *(u32x2*)(orow + 32 + 8 * i4) = x; }
}

struct AttnHead { bf16x8 qf[4]; float m, lsum; f32x16 o0, o1; };
__device__ __forceinline__ void attn_tile(AttnHead& h, const bf16x8 (&KF)[4], const bf16x8 (&VF)[4], int maskmode, int r32, int hi) {
    f32x16 sc;
#pragma unroll
    for (int g = 0; g < 16; ++g) sc[g] = 0.f;
#pragma unroll
    for (int d0 = 0; d0 < 4; ++d0) sc = MFMA32(KF[d0], h.qf[d0], sc);
    if (maskmode != 0) {
        asm volatile("" ::: "memory");
        if (maskmode == 1) {
#pragma unroll
            for (int g = 0; g < 16; ++g) sc[g] = (crow(g, hi) >= r32) ? sc[g] : -INFINITY; }
        else {
#pragma unroll
            for (int g = 0; g < 16; ++g) sc[g] = (crow(g, hi) <= r32) ? sc[g] : -INFINITY; }
    }
    float tm = sc[0];
#pragma unroll
    for (int g = 1; g < 16; ++g) tm = __builtin_fmaxf(tm, sc[g]);
    tm = __builtin_fmaxf(tm, __shfl_xor(tm, 32));
    const float mn = __builtin_fmaxf(h.m, tm);
    if (__any(mn > h.m)) { const float al = __builtin_amdgcn_exp2f(h.m - mn); h.lsum *= al;
#pragma unroll
        for (int g = 0; g < 16; ++g) { h.o0[g] *= al; h.o1[g] *= al; } }
    h.m = mn; float ps = 0.f;
#pragma unroll
    for (int g = 0; g < 16; ++g) { sc[g] = __builtin_amdgcn_exp2f(sc[g] - mn); ps += sc[g]; }
    h.lsum += ps;
    u32x4 p0, p1;
    p0.x = cvt_pk_bf16(sc[0], sc[1]); p0.y = cvt_pk_bf16(sc[2], sc[3]); p0.z = cvt_pk_bf16(sc[4], sc[5]); p0.w = cvt_pk_bf16(sc[6], sc[7]);
    p1.x = cvt_pk_bf16(sc[8], sc[9]); p1.y = cvt_pk_bf16(sc[10], sc[11]); p1.z = cvt_pk_bf16(sc[12], sc[13]); p1.w = cvt_pk_bf16(sc[14], sc[15]);
    h.o0 = MFMA32(VF[0], __builtin_bit_cast(bf16x8, p0), h.o0); h.o0 = MFMA32(VF[1], __builtin_bit_cast(bf16x8, p1), h.o0);
    h.o1 = MFMA32(VF[2], __builtin_bit_cast(bf16x8, p0), h.o1); h.o1 = MFMA32(VF[3], __builtin_bit_cast(bf16x8, p1), h.o1);
}
__device__ __forceinline__ void attn_task2(Frame& F, int layer, int g32, int hp) {
    const int lane = F.lane, r32 = lane & 31, hi = lane >> 5, kvh = hp >> 1;
    const bf16_t* P = (const bf16_t*)(F.ws + WS_P); bf16_t* MIX = (bf16_t*)(F.ws + WS_MIX);
    const bf16_t* KFh = (const bf16_t*)(F.ws + WS_KF) + (size_t)kvh * NT32 * 2048 + lane * 8;
    const bf16_t* VFh = (const bf16_t*)(F.ws + WS_VF) + (size_t)kvh * NT32 * 2048 + lane * 8;
    const int qrow = 32 * g32 + r32;
    AttnHead h[2];
#pragma unroll
    for (int q = 0; q < 2; ++q) { const int hq = 2 * hp + q;
#pragma unroll
        for (int d0 = 0; d0 < 4; ++d0) h[q].qf[d0] = *(const bf16x8*)(P + (size_t)qrow * INC + PC_Q + hq * 64 + 16 * d0 + 8 * hi);
        h[q].m = F.ka->in[I_SINK][layer * 8 + hq] * LOG2E; h[q].lsum = hi == 0 ? 1.0f : 0.0f;
#pragma unroll
        for (int g = 0; g < 16; ++g) { h[q].o0[g] = 0.f; h[q].o1[g] = 0.f; } }
    int tb0, tb1, tc0;
    if (g32 < TL / 32) { const int b = g32 >> 9, s0 = b * 512; tb0 = g32 - 4 < s0 ? s0 : g32 - 4; tb1 = g32 + 5 > s0 + 512 ? s0 + 512 : g32 + 5; tc0 = TL / 32 + b * 8; }
    else { const int b = (g32 - TL / 32) >> 3; tb0 = 0; tb1 = 0; tc0 = TL / 32 + b * 8; }
    const int nb = tb1 - tb0, nt = nb + 8;
    bf16x8 k0[4], v0[4], k1[4], v1[4];
#define AT_TILE(i) ((i) < nb ? tb0 + (i) : tc0 + ((i) - nb))
#define AT_LOAD(KF, VF, i) do { const size_t to_ = (size_t)AT_TILE(i) * 2048; _Pragma("unroll") for (int j = 0; j < 4; ++j) { KF[j] = *(const bf16x8*)(KFh + to_ + j * 512); VF[j] = *(const bf16x8*)(VFh + to_ + j * 512); } } while (0)
#define AT_COMPUTE(KF, VF, i) do { const int tt = AT_TILE(i); const int mk = ((i) < nb) ? (tt == g32 - 4 ? 1 : (tt == g32 + 4 ? 2 : 0)) : 0; \
        attn_tile(h[0], KF, VF, mk, r32, hi); attn_tile(h[1], KF, VF, mk, r32, hi); } while (0)
    AT_LOAD(k0, v0, 0);
    for (int i = 0; i < nt; i += 2) {
        if (i + 1 < nt) AT_LOAD(k1, v1, i + 1);
        AT_COMPUTE(k0, v0, i);
        if (i + 1 < nt) { if (i + 2 < nt) AT_LOAD(k0, v0, i + 2); AT_COMPUTE(k1, v1, i + 1); }
    }
#undef AT_TILE
#undef AT_LOAD
#undef AT_COMPUTE
#pragma unroll
    for (int q = 0; q < 2; ++q) { const int hq = 2 * hp + q;
        const float rl = 1.0f / (h[q].lsum + __shfl_xor(h[q].lsum, 32));
        if (FP8_WOUT) { unsigned char* orow8 = (unsigned char*)MIX + (size_t)qrow * MIXW + hq * 64 + 4 * hi;
#pragma unroll
            for (int i4 = 0; i4 < 4; ++i4) { *(unsigned*)(orow8 + 8 * i4) = pk_mix8(h[q].o0[4 * i4] * rl, h[q].o0[4 * i4 + 1] * rl, h[q].o0[4 * i4 + 2] * rl, h[q].o0[4 * i4 + 3] * rl);
                *(unsigned*)(orow8 + 32 + 8 * i4) = pk_mix8(h[q].o1[4 * i4] * rl, h[q].o1[4 * i4 + 1] * rl, h[q].o1[4 * i4 + 2] * rl, h[q].o1[4 * i4 + 3] * rl); } }
        else { bf16_t* orow = MIX + (size_t)qrow * MIXW + hq * 64 + 4 * hi;
#pragma unroll
        for (int i4 = 0; i4 < 4; ++i4) {
            u32x2 w; w.x = cvt_pk_bf16(h[q].o0[4 * i4] * rl, h[q].o0[4 * i4 + 1] * rl); w.y = cvt_pk_bf16(h[q].o0[4 * i4 + 2] * rl, h[q].o0[4 * i4 + 3] * rl); *(u32x2*)(orow + 8 * i4) = w;
            u32x2 x; x.x = cvt_pk_bf16(h[q].o1[4 * i4] * rl, h[q].o1[4 * i4 + 1] * rl); x.y = cvt_pk_bf16(h[q].o1[4 * i4 + 2] * rl, h[q].o1[4 * i4 + 3] * rl); *(u32x2*)(orow + 32 + 8 * i4) = x; } } }
}

constexpr int VNT_STRIDE = 136;
constexpr int DT_STRIDE = 264;
constexpr int G_XS_OFF = 0, G_D_OFF = 144 * 256 * 2;
__device__ __forceinline__ void gated_chunk(Frame& F, int layer, int chunk) {
    const bf16_t* P = (const bf16_t*)(F.ws + WS_P); bf16_t* MIX = (bf16_t*)(F.ws + WS_MIX);
    const int R0 = chunk * 128; const bool lat = R0 < TL;
    const int seq0 = lat ? (R0 & ~(S - 1)) : TL + ((R0 - TL) & ~(LC - 1)); const int nseq = lat ? S : LC;
    int tid = F.tid; asm volatile("" : "+v"(tid)); const int lane = tid & 63, wave = F.wave, r32 = lane & 31, hi = lane >> 5;
    {
        LAS bf16_t* vnT = (LAS bf16_t*)F.lds;
        const float* lng = F.ka->in[I_SGULNG] + layer * 256; const float* lnb = F.ka->in[I_SGULNB] + layer * 256;
        float gq[4], bq[4];
#pragma unroll
        for (int i = 0; i < 4; ++i) { gq[i] = lng[lane + 64 * i]; bq[i] = lnb[lane + 64 * i]; }
        for (int pass = 0; pass < 2; ++pass) { const int rb = wave * 16 + pass * 8;
            float x[8][4];
#pragma unroll
            for (int rr = 0; rr < 8; ++rr)
#pragma unroll
                for (int i = 0; i < 4; ++i) x[rr][i] = bf2f(P[(size_t)(R0 + rb + rr) * INC + PC_SV + lane + 64 * i]);
            float mu[8], q[8];
#pragma unroll
            for (int rr = 0; rr < 8; ++rr) mu[rr] = (x[rr][0] + x[rr][1]) + (x[rr][2] + x[rr][3]);
#pragma unroll
            for (int o = 1; o < 64; o <<= 1)
#pragma unroll
                for (int rr = 0; rr < 8; ++rr) mu[rr] += __shfl_xor(mu[rr], o);
#pragma unroll
            for (int rr = 0; rr < 8; ++rr) { mu[rr] *= (1.f / 256.f); q[rr] = 0.f;
#pragma unroll
                for (int i = 0; i < 4; ++i) { x[rr][i] -= mu[rr]; q[rr] += x[rr][i] * x[rr][i]; } }
#pragma unroll
            for (int o = 1; o < 64; o <<= 1)
#pragma unroll
                for (int rr = 0; rr < 8; ++rr) q[rr] += __shfl_xor(q[rr], o);
#pragma unroll
            for (int rr = 0; rr < 8; ++rr) { const float rstd = 1.0f / sqrtf(q[rr] * (1.f / 256.f) + EPS);
#pragma unroll
                for (int i = 0; i < 4; ++i) x[rr][i] = x[rr][i] * rstd * gq[i] + bq[i]; }
#pragma unroll
            for (int i = 0; i < 4; ++i) { u32x4 w; w.x = cvt_pk_bf16(x[0][i], x[1][i]); w.y = cvt_pk_bf16(x[2][i], x[3][i]); w.z = cvt_pk_bf16(x[4][i], x[5][i]); w.w = cvt_pk_bf16(x[6][i], x[7][i]);
                *(LAS u32x4*)(vnT + (lane + 64 * i) * VNT_STRIDE + rb) = w; }
        }
        __syncthreads();
        const int h = wave >> 1, dt = wave & 1;
        bf16x8 bfr[8];
#pragma unroll
        for (int sx = 0; sx < 8; ++sx) bfr[sx] = *(const LAS bf16x8*)(vnT + (h * 64 + dt * 32 + r32) * VNT_STRIDE + 16 * sx + 8 * hi);
        const bf16_t* wsb = (const bf16_t*)(F.ws + WS_SGUW) + ((size_t)layer * 4 + h) * 128 * 128;
        const float* bsv = F.ka->in[I_SGUB] + (layer * 4 + h) * 128;
        const int cb = h * 64 + dt * 32 + 4 * hi;
#pragma unroll
        for (int half = 0; half < 2; ++half) {
            bf16x8 af[2][8]; u32x2 uv[2][4]; float bsp[2];
#pragma unroll
            for (int q = 0; q < 2; ++q) { const int p = (half * 2 + q) * 32 + r32;
#pragma unroll
                for (int sx = 0; sx < 8; ++sx) af[q][sx] = *(const bf16x8*)(wsb + (size_t)p * 128 + 16 * sx + 8 * hi);
#pragma unroll
                for (int i4 = 0; i4 < 4; ++i4) uv[q][i4] = *(const u32x2*)(P + (size_t)(R0 + p) * INC + PC_SU + cb + 8 * i4);
                bsp[q] = bsv[p]; }
#pragma unroll
            for (int q = 0; q < 2; ++q) { const int p = (half * 2 + q) * 32 + r32;
                f32x16 acc;
#pragma unroll
                for (int g = 0; g < 16; ++g) acc[g] = 0.f;
#pragma unroll
                for (int sx = 0; sx < 8; ++sx) acc = MFMA32(bfr[sx], af[q][sx], acc);
#pragma unroll
                for (int i4 = 0; i4 < 4; ++i4) { const float z0 = bflo(uv[q][i4].x) * (acc[4 * i4] + bsp[q]), z1 = bfhi(uv[q][i4].x) * (acc[4 * i4 + 1] + bsp[q]), z2 = bflo(uv[q][i4].y) * (acc[4 * i4 + 2] + bsp[q]), z3 = bfhi(uv[q][i4].y) * (acc[4 * i4 + 3] + bsp[q]);
                    if (FP8_WOUT) *(unsigned*)((unsigned char*)MIX + (size_t)(R0 + p) * MIXW + 512 + cb + 8 * i4) = pk_mix8(z0, z1, z2, z3);
                    else { u32x2 w; w.x = cvt_pk_bf16(z0, z1); w.y = cvt_pk_bf16(z2, z3); *(u32x2*)(MIX + (size_t)(R0 + p) * MIXW + 512 + cb + 8 * i4) = w; } } }
        }
        __syncthreads();
    }
    {
        LAS bf16_t* xs = (LAS bf16_t*)(F.lds + G_XS_OFF); LAS bf16_t* dT = (LAS bf16_t*)(F.lds + G_D_OFF);
        { u32x4 w[9];
#pragma unroll
          for (int k = 0; k < 9; ++k) { const int i = tid + 512 * k; const int rr = i >> 5, c8 = (i & 31) * 8; const int gr = R0 - 8 + rr;
              w[k] = (u32x4){0u, 0u, 0u, 0u};
              if (gr >= seq0 && gr < seq0 + nseq) w[k] = *(const u32x4*)(P + (size_t)gr * INC + PC_XP + c8); }
#pragma unroll
          for (int k = 0; k < 9; ++k) { const int i = tid + 512 * k; const int rr = i >> 5, c8 = (i & 31) * 8; *(LAS u32x4*)(xs + rr * 256 + c8) = w[k]; } }
        __syncthreads();
        {
            const int cp = tid & 127, c2 = cp * 2, sg = tid >> 7, hw = 1 << (cp >> 5);
            const int t0 = R0 + sg * 32 - seq0;
            const LAS bf16_t* xc = xs + (sg * 32 + 8) * 256 + c2;
            float s0 = 0.f, s1 = 0.f;
            for (int o = -hw; o < hw; ++o) { const int j = t0 + o; if (j >= 0 && j < nseq) { const unsigned wv = *(const LAS unsigned*)(xc + o * 256); s0 += bflo(wv); s1 += bfhi(wv); } }
            unsigned outv[32];
#pragma unroll
            for (int k = 0; k < 32; ++k) { const int t = t0 + k;
                int lo = t - hw, hi2 = t + hw; if (lo < 0) lo = 0; if (hi2 > nseq) hi2 = nseq;
                const unsigned xv = *(const LAS unsigned*)(xc + k * 256); const float inv = 1.0f / (float)(hi2 - lo);
                outv[k] = cvt_pk_bf16(s0 * inv - bflo(xv), s1 * inv - bfhi(xv));
                const int je = t + hw, jl = t - hw;
                const unsigned we = *(const LAS unsigned*)(xc + (k + hw) * 256), wl = *(const LAS unsigned*)(xc + (k - hw) * 256);
                if (je < nseq) { s0 += bflo(we); s1 += bfhi(we); }
                if (jl >= 0) { s0 -= bflo(wl); s1 -= bfhi(wl); } }
#pragma unroll
            for (int k = 0; k < 32; ++k) *(LAS unsigned*)(dT + (sg * 32 + k) * DT_STRIDE + c2) = outv[k];
        }
        __syncthreads();
        const int g = wave >> 1, ddt = wave & 1;
        const bf16_t* pwt = (const bf16_t*)(F.ws + WS_POOLWT) + ((size_t)layer * 4 + g) * 64 * 64;
        bf16x8 bfr[4];
#pragma unroll
        for (int sx = 0; sx < 4; ++sx) bfr[sx] = *(const bf16x8*)(pwt + (size_t)(ddt * 32 + r32) * 64 + 16 * sx + 8 * hi);
        const int cb = g * 64 + ddt * 32 + 4 * hi;
        f32x4 psc[4];
#pragma unroll
        for (int i4 = 0; i4 < 4; ++i4) psc[i4] = *(const f32x4*)(F.ka->in[I_POOLS] + layer * 256 + cb + 8 * i4);
#pragma unroll
        for (int tt = 0; tt < 4; ++tt) {
            f32x16 acc;
#pragma unroll
            for (int q = 0; q < 16; ++q) acc[q] = 0.f;
#pragma unroll
            for (int sx = 0; sx < 4; ++sx) { const bf16x8 df = *(const LAS bf16x8*)(dT + (tt * 32 + r32) * DT_STRIDE + g * 64 + 16 * sx + 8 * hi); acc = MFMA32(bfr[sx], df, acc); }
#pragma unroll
            for (int i4 = 0; i4 < 4; ++i4) {
                if (FP8_WOUT) *(unsigned*)((unsigned char*)MIX + (size_t)(R0 + tt * 32 + r32) * MIXW + 768 + cb + 8 * i4) = pk_mix8(acc[4 * i4] * psc[i4].x, acc[4 * i4 + 1] * psc[i4].y, acc[4 * i4 + 2] * psc[i4].z, acc[4 * i4 + 3] * psc[i4].w);
                else { u32x2 w; w.x = cvt_pk_bf16(acc[4 * i4] * psc[i4].x, acc[4 * i4 + 1] * psc[i4].y); w.y = cvt_pk_bf16(acc[4 * i4 + 2] * psc[i4].z, acc[4 * i4 + 3] * psc[i4].w);
                *(u32x2*)(MIX + (size_t)(R0 + tt * 32 + r32) * MIXW + 768 + cb + 8 * i4) = w; } }
        }
    }
    __syncthreads();
}
__device__ __forceinline__ void conv_pass(Frame& F, int layer, int nrows) {
    const bf16_t* P = (const bf16_t*)(F.ws + WS_P); bf16_t* MIX = (bf16_t*)(F.ws + WS_MIX);
    const int gw = F.vcu * 8 + F.wave, NGW = F.G * 8, c4 = 4 * F.lane;
    const float* cw = F.ka->in[I_CONVW] + layer * 3 * 256;
    const f32x4 w0 = *(const f32x4*)(cw + c4), w1 = *(const f32x4*)(cw + 256 + c4), w2 = *(const f32x4*)(cw + 512 + c4);
    for (int task = gw; task < nrows / 8; task += NGW) {
        const int r0 = task * 8; const bool lat = r0 < TL;
        const int seq0 = lat ? (r0 & ~(S - 1)) : TL + ((r0 - TL) & ~(LC - 1)); const int nseq = lat ? S : LC;
        u32x2 a[10], b[10], c[8];
#pragma unroll
        for (int i = 0; i < 10; ++i) { const int kr = r0 - 1 + i; a[i] = (u32x2){0u, 0u}; b[i] = (u32x2){0u, 0u};
            if (kr >= seq0 && kr < seq0 + nseq) { a[i] = *(const u32x2*)(P + (size_t)kr * INC + PC_CC + c4); b[i] = *(const u32x2*)(P + (size_t)kr * INC + PC_CX + c4); } }
#pragma unroll
        for (int i = 0; i < 8; ++i) c[i] = *(const u32x2*)(P + (size_t)(r0 + i) * INC + PC_CB + c4);
        f32x4 y[10];
#pragma unroll
        for (int i = 0; i < 10; ++i) y[i] = (f32x4){bflo(a[i].x), bfhi(a[i].x), bflo(a[i].y), bfhi(a[i].y)} * (f32x4){bflo(b[i].x), bfhi(b[i].x), bflo(b[i].y), bfhi(b[i].y)};
#pragma unroll
        for (int i = 0; i < 8; ++i) { const f32x4 z = (w0 * y[i] + w1 * y[i + 1] + w2 * y[i + 2]) * (f32x4){bflo(c[i].x), bfhi(c[i].x), bflo(c[i].y), bfhi(c[i].y)};
            if (FP8_WOUT) *(unsigned*)((unsigned char*)MIX + (size_t)(r0 + i) * MIXW + 1024 + c4) = pk_mix8(z.x, z.y, z.z, z.w);
            else { u32x2 w; w.x = cvt_pk_bf16(z.x, z.y); w.y = cvt_pk_bf16(z.z, z.w);
            *(u32x2*)(MIX + (size_t)(r0 + i) * MIXW + 1024 + c4) = w; } }
    }
}
__device__ __forceinline__ void p_mixers(Frame& F, int layer, int nrows) {
    conv_pass(F, layer, nrows);
    for (int ch = F.vcu; ch < TL / 128; ch += F.G) gated_chunk(F, layer, ch);
    const bool ctxl = nrows > TL, bal = ctxl && F.G == 256;
    const bool cg = ctxl && F.vcu >= 16 && F.vcu < 16 + TC / 128;
    if (cg) gated_chunk(F, layer, TL / 128 + F.vcu - 16);
    if (ATTN_PAIR) {
        int gl[6]; int ng = 0;
        { int j = 0; for (int g = F.vcu; g < TL / 32; g += F.G, ++j) { if (bal && cg && j >= 1) break; if (ng < 6) gl[ng++] = g; } }
        if (bal && F.vcu >= 20 && F.vcu < 32) { const int q = F.vcu - 20; if (ng < 6) gl[ng++] = (16 + q / 3) + F.G * (1 + q % 3); }
        if (ctxl && F.vcu < TC / 32) { if (ng < 6) gl[ng++] = TL / 32 + F.vcu; }
        for (int i = (F.wave >> 2); i < ng; i += 2) { int g = gl[0];
#pragma unroll
            for (int k = 1; k < 6; ++k) g = (i == k) ? gl[k] : g;
            attn_task2(F, layer, g, F.wave & 3); }
    } else {
    { int j = 0; for (int g = F.vcu; g < TL / 32; g += F.G, ++j) { if (bal && cg && j >= 1) break; attn_task(F, layer, g, F.wave); } }
    if (bal && F.vcu >= 20 && F.vcu < 32) { const int q = F.vcu - 20; attn_task(F, layer, (16 + q / 3) + F.G * (1 + q % 3), F.wave); }
    if (ctxl && F.vcu < TC / 32) attn_task(F, layer, TL / 32 + F.vcu, F.wave);
    }
}

__device__ __forceinline__ void p_router_fold(Frame& F) {
    const float* mod = (const float*)(F.ws + WS_MOD);
    float* rwp = (float*)(F.ws + WS_RWP); float* bp = (float*)(F.ws + WS_BIASP);
    for (int i = F.vcu * 512 + F.tid; i < DEPTH * 3 * D * NE; i += F.G * 512) {
        const int lm = i / (D * NE), rem = i - lm * (D * NE), k = rem >> 5, e = rem & 31, l = lm / 3;
        const float a = F.ka->in[I_N2G][l * D + k] * (1.0f + mod[(size_t)lm * 6144 + 4 * D + k]);
        rwp[(size_t)lm * (D * NE) + ((k >> 2) * 32 + e) * 4 + (k & 3)] = a * F.ka->in[I_RW][(size_t)l * D * NE + k * NE + e];
    }
    const int gw = F.vcu * 8 + F.wave;
    if (gw < DEPTH * 3 * NE) { const int lm = gw >> 5, e = gw & 31, l = lm / 3; float s = 0.f;
        for (int j = 0; j < 16; ++j) { const int k = F.lane + 64 * j; s += mod[(size_t)lm * 6144 + 3 * D + k] * F.ka->in[I_RW][(size_t)l * D * NE + k * NE + e]; }
        s = wave_sum(s);
        if (F.lane == 0) bp[gw] = s + F.ka->in[I_RB][l * NE + e]; }
}
constexpr int RT_LT = 0;
constexpr int RT_RS = RT_LT + 8 * 32 * 33 * 4;
constexpr int RT_LST = RT_RS + 8 * 32 * 4;
constexpr int RT_HIST = RT_LST + 1024 * 12;
__device__ __forceinline__ void p_router(Frame& F, int layer, int nrows) {
    LAS float* lt = (LAS float*)(F.lds + RT_LT) + F.wave * (32 * 33); LAS float* rs = (LAS float*)(F.lds + RT_RS) + F.wave * 32;
    LAS int* lst_a = (LAS int*)(F.lds + RT_LST); LAS int* lst_e = lst_a + 1024; LAS float* lst_g = (LAS float*)(lst_e + 1024);
    LAS int* hist = (LAS int*)(F.lds + RT_HIST); LAS int* base = hist + 32; LAS int* nlist = base + 32;
    if (F.tid < 32) hist[F.tid] = 0;
    if (F.tid == 32) nlist[0] = 0;
    __syncthreads();
    const float* XL = (const float*)(F.ws + WS_XL); bf16_t* H = (bf16_t*)(F.ws + WS_H);
    const float* mod = (const float*)(F.ws + WS_MOD) + (size_t)layer * 3 * 6144;
    const int lane = F.lane, r32 = lane & 31, hi = lane >> 5;
    const int ntile = nrows / 32;
    for (int t = F.vcu + F.G * F.wave; t < ntile; t += 8 * F.G) {
        const int row0 = 32 * t, mi = mod_index(row0);
        const float* xr = xrow_in(F, layer, row0 + r32) + 4 * hi; const bf16_t* dxr = (const bf16_t*)(F.ws + WS_DX) + (size_t)(row0 + r32) * D + 4 * hi;
        const float* wp = (const float*)(F.ws + WS_RWP) + (size_t)(layer * 3 + mi) * (D * NE) + (hi * 32 + r32) * 4;
        f32x16 acc;
#pragma unroll
        for (int g = 0; g < 16; ++g) acc[g] = 0.f;
        float ss = 0.f;
        f32x4 xa[4], wa[4], xb[4], wb[4]; u32x2 da[4], db[4];
#define RT_LOAD(X, Dv, W, j0) do { _Pragma("unroll") for (int q = 0; q < 4; ++q) { X[q] = *(const f32x4*)(xr + 8 * ((j0) + q)); Dv[q] = *(const u32x2*)(dxr + 8 * ((j0) + q)); W[q] = *(const f32x4*)(wp + ((j0) + q) * 256); } } while (0)
#define RT_MMA(X, Dv, W) do { _Pragma("unroll") for (int q = 0; q < 4; ++q) { const f32x4 xv = X[q] + (f32x4){bflo(Dv[q].x), bfhi(Dv[q].x), bflo(Dv[q].y), bfhi(Dv[q].y)}; \
            ss += (xv.x * xv.x + xv.y * xv.y) + (xv.z * xv.z + xv.w * xv.w); \
            acc = __builtin_amdgcn_mfma_f32_32x32x2f32(xv.x, W[q].x, acc, 0, 0, 0); acc = __builtin_amdgcn_mfma_f32_32x32x2f32(xv.y, W[q].y, acc, 0, 0, 0); \
            acc = __builtin_amdgcn_mfma_f32_32x32x2f32(xv.z, W[q].z, acc, 0, 0, 0); acc = __builtin_amdgcn_mfma_f32_32x32x2f32(xv.w, W[q].w, acc, 0, 0, 0); } } while (0)
        RT_LOAD(xa, da, wa, 0);
        for (int j = 0; j < 128; j += 8) {
            RT_LOAD(xb, db, wb, j + 4);
            RT_MMA(xa, da, wa);
            if (j + 8 < 128) RT_LOAD(xa, da, wa, j + 8);
            RT_MMA(xb, db, wb);
        }
#undef RT_LOAD
#undef RT_MMA
        ss += __shfl_xor(ss, 32);
        const float rstd = 1.0f / sqrtf(ss * (1.f / D) + EPS);
        if (hi == 0) rs[r32] = rstd;
        LDS_WAIT();
        const float bpe = ((const float*)(F.ws + WS_BIASP))[(layer * 3 + mi) * NE + r32];
#pragma unroll
        for (int g = 0; g < 16; ++g) { const int rr = crow(g, hi); lt[rr * 33 + r32] = acc[g] * rs[rr] + bpe; }
        LDS_WAIT();
        if (lane < 32) {
            float lg[32];
#pragma unroll
            for (int e = 0; e < 32; ++e) lg[e] = lt[lane * 33 + e];
            int te[4]; float tv[4];
#pragma unroll
            for (int k = 0; k < 4; ++k) { float best = lg[0]; int bi = 0;
#pragma unroll
                for (int e = 1; e < 32; ++e) { const bool tk = lg[e] > best; best = tk ? lg[e] : best; bi = tk ? e : bi; }
                te[k] = bi; tv[k] = best;
#pragma unroll
                for (int e = 0; e < 32; ++e) lg[e] = (e == bi) ? -3.0e38f : lg[e]; }
            const float e1 = __expf(tv[1] - tv[0]), e2 = __expf(tv[2] - tv[0]), e3 = __expf(tv[3] - tv[0]); const float inv = 1.0f / (1.0f + e1 + e2 + e3);
            const float gt[4] = {inv, e1 * inv, e2 * inv, e3 * inv};
            const int li = __hip_atomic_fetch_add(nlist, 4, __ATOMIC_RELAXED, __HIP_MEMORY_SCOPE_WORKGROUP);
#pragma unroll
            for (int k = 0; k < 4; ++k) { const int rk = __hip_atomic_fetch_add(hist + te[k], 1, __ATOMIC_RELAXED, __HIP_MEMORY_SCOPE_WORKGROUP);
                lst_a[li + k] = (row0 + lane) * 4 + k; lst_e[li + k] = te[k] | (rk << 8); lst_g[li + k] = gt[k]; }
        }
        f32x4 av[4], sv[4];
#pragma unroll
        for (int j = 0; j < 4; ++j) { const int c = 4 * lane + 256 * j;
            av[j] = *(const f32x4*)(F.ka->in[I_N2G] + layer * D + c) * (*(const f32x4*)(mod + (size_t)mi * 6144 + 4 * D + c) + 1.0f); sv[j] = *(const f32x4*)(mod + (size_t)mi * 6144 + 3 * D + c); }
#pragma unroll 4
        for (int rr = 0; rr < 32; ++rr) { const float rq = rs[rr]; const float* x = xrow_in(F, layer, row0 + rr); const bf16_t* dx = (const bf16_t*)(F.ws + WS_DX) + (size_t)(row0 + rr) * D; bf16_t* hrow = H + (size_t)(row0 + rr) * D;
#pragma unroll
            for (int j = 0; j < 4; ++j) { const int c = 4 * lane + 256 * j; const u32x2 dv = *(const u32x2*)(dx + c);
                const f32x4 y = ((*(const f32x4*)(x + c) + (f32x4){bflo(dv.x), bfhi(dv.x), bflo(dv.y), bfhi(dv.y)}) * rq) * av[j] + sv[j];
                if constexpr (FP8_MOE1) *(unsigned*)((unsigned char*)(F.ws + WS_H8) + (size_t)(row0 + rr) * D + c) = pk_fp8x4(y.x, y.y, y.z, y.w);
                else { u32x2 w; w.x = cvt_pk_bf16(y.x, y.y); w.y = cvt_pk_bf16(y.z, y.w); *(u32x2*)(hrow + c) = w; } } }
    }
    __syncthreads();
    unsigned* cnt = F.ctl + CW_CNT + layer * NE * 16;
    if (F.tid < 32) base[F.tid] = (int)__hip_atomic_fetch_add(cnt + F.tid * 16, (unsigned)hist[F.tid], __ATOMIC_RELAXED, __HIP_MEMORY_SCOPE_AGENT);
    __syncthreads();
    int* slot_tok = (int*)(F.ws + WS_SLOT_TOK); int* slot_asg = (int*)(F.ws + WS_SLOT_ASG); float* slot_gate = (float*)(F.ws + WS_SLOT_GATE);
    const int nl = nlist[0];
    for (int i = F.tid; i < nl; i += 512) { const int asg = lst_a[i], ee = lst_e[i]; const int e = ee & 255; const int pos = base[e] + (ee >> 8);
        slot_tok[(size_t)e * CAP + pos] = asg >> 2; slot_asg[(size_t)e * CAP + pos] = asg; slot_gate[(size_t)e * CAP + pos] = lst_g[i]; }
    __syncthreads();
}

__device__ __forceinline__ int moe_tables(Frame& F, int layer) {
    LAS int* tstart = (LAS int*)(F.lds + TAB_OFF); LAS int* lcnt = (LAS int*)(F.lds + TAB_LCNT); LAS int* tinfo = (LAS int*)(F.lds + TAB_TINFO);
    unsigned* cnt = F.ctl + CW_CNT + layer * NE * 16;
    if (F.tid < NE) lcnt[F.tid] = (int)__hip_atomic_load(cnt + F.tid * 16, __ATOMIC_RELAXED, __HIP_MEMORY_SCOPE_AGENT);
    __syncthreads();
    if (F.tid == 0) { int acc = 0;
#pragma unroll 1
        for (int e = 0; e < NE; ++e) { tstart[e] = acc; acc += (lcnt[e] + 255) >> 8; } tstart[NE] = acc; }
    __syncthreads();
    const int nt = tstart[NE];
    for (int T = F.tid; T < nt; T += 512) { int e = 0;
#pragma unroll 1
        for (int j = 1; j < NE; ++j) e += (T >= tstart[j]) ? 1 : 0;
        tinfo[T] = e | ((T - tstart[e]) << 8); }
    __syncthreads();
    return __builtin_amdgcn_readfirstlane(nt);
}

__device__ __forceinline__ void p_combine(Frame& F, int layer, int nrows) {
    const int gw = F.vcu * 8 + F.wave, NGW = F.G * 8; const int lane = F.lane;
    const float* mod = (const float*)(F.ws + WS_MOD);
    float* XL = (float*)(F.ws + WS_XL); const bf16_t* Y = (const bf16_t*)(F.ws + WS_Y); bf16_t* H = (bf16_t*)(F.ws + WS_H);
    const bool last = layer == DEPTH - 1;
    for (int r = gw; r < nrows; r += NGW) {
        const int mi = mod_index(r); const float* g2 = mod + (size_t)(layer * 3 + mi) * 6144 + 5 * D;
        f32x4 v[4];
#pragma unroll
        for (int j = 0; j < 4; ++j) { const int c = 4 * lane + 256 * j; f32x4 s = (f32x4){0.f, 0.f, 0.f, 0.f};
#pragma unroll
            for (int k = 0; k < 4; ++k) { const unsigned w = *(const unsigned*)((const unsigned char*)Y + (size_t)(r * 4 + k) * D + c);
                const f32x2 lo = __builtin_amdgcn_cvt_pk_f32_fp8((int)w, false), hi = __builtin_amdgcn_cvt_pk_f32_fp8((int)w, true); s += (f32x4){lo.x, lo.y, hi.x, hi.y}; }
            const u32x2 dv = *(const u32x2*)((const bf16_t*)(F.ws + WS_DX) + (size_t)r * D + c);
            v[j] = *(const f32x4*)(xrow_in(F, layer, r) + c) + (f32x4){bflo(dv.x), bfhi(dv.x), bflo(dv.y), bfhi(dv.y)} + *(const f32x4*)(g2 + c) * (s * (1.0f / Y8_SCALE)); }
        if (!last) {
#pragma unroll
            for (int j = 0; j < 4; ++j) *(f32x4*)(XL + (size_t)r * D + 4 * lane + 256 * j) = v[j];
            const float* m1 = mod + (size_t)((layer + 1) * 3 + mi) * 6144;
            norm_mod_store(v, F.ka->in[I_N1G] + (layer + 1) * D, m1, m1 + D, H + (size_t)r * D, lane);
        } else {
            float ss = 0.f;
#pragma unroll
            for (int j = 0; j < 4; ++j) ss += (v[j].x * v[j].x + v[j].y * v[j].y) + (v[j].z * v[j].z + v[j].w * v[j].w);
            const float rstd = 1.0f / sqrtf(wave_sum(ss) * (1.f / D) + EPS);
#pragma unroll
            for (int j = 0; j < 4; ++j) { const int c = 4 * lane + 256 * j; *(f32x4*)(F.out + (size_t)r * D + c) = v[j] * rstd * *(const f32x4*)(F.ka->in[I_FG] + c); }
        }
    }
}

__global__ void __launch_bounds__(512, 2) fwd_kernel(Args args) {
    extern __shared__ __attribute__((aligned(16))) unsigned char lds[];
    Frame F;
#define FRESH() do { int t_ = threadIdx.x; asm volatile("" : "+v"(t_)); F.tid = t_; F.lane = t_ & 63; F.wave = __builtin_amdgcn_readfirstlane(t_ >> 6); \
        int g_ = gridDim.x, b_ = blockIdx.x; asm volatile("" : "+s"(g_), "+s"(b_)); F.G = g_; F.bx = b_; F.vcu = (g_ % 8 == 0) ? (b_ % 8) * (g_ / 8) + b_ / 8 : b_; \
        const __attribute__((address_space(4))) Args* k_ = (const __attribute__((address_space(4))) Args*)__builtin_amdgcn_kernarg_segment_ptr(); asm volatile("" : "+s"(k_)); F.ka = k_; \
        unsigned char* w_ = k_->ws; F.ws = w_; F.ctl = (unsigned*)(w_ + WS_CTL); F.out = k_->out; \
        F.lds = (LAS unsigned char*)lds; F.MISC = (volatile LAS unsigned*)(F.lds + MISC_OFF); } while (0)
    FRESH();
    for (int u = F.tid; u < 128; u += 512) ((LAS unsigned*)(F.lds + MISC_OFF))[u] = 0u;
    __syncthreads();
    const int lo = F.ka->ph_lo, hi = F.ka->ph_hi;
    const bool one_launch = (hi - lo) > 1;
    if (one_launch) (void)xcd_barrier_post(F.ctl + CW_BAR, F.MISC + 8);
#define IN(k) (lo <= (k) && (k) < hi)
#define PH(k) if (IN(k) && ({ FRESH(); true; }))
#define BARRIER_NOW() do { const __attribute__((address_space(4))) Args* kb_ = (const __attribute__((address_space(4))) Args*)__builtin_amdgcn_kernarg_segment_ptr(); asm volatile("" : "+s"(kb_)); \
        XcdBarrier b_; b_.bar = (unsigned*)(kb_->ws + WS_CTL) + CW_BAR; b_.x = xb_xcc_id(); b_.st = (volatile LAS unsigned*)((LAS unsigned char*)lds + MISC_OFF) + 8; xcd_barrier(b_); } while (0)
#define SEAM(k) do { if (IN(k) && IN((k) + 1)) BARRIER_NOW(); } while (0)

#define NREP(t) (((REPEAT_MASK >> (t)) & 1) ? 2 : 1)
#define REP_BEGIN(t) for (int rep_ = 0; rep_ < NREP(t); ++rep_) {
#define REP_END(t) if (rep_ + 1 < NREP(t)) BARRIER_NOW(); }
    PH(0) { REP_BEGIN(0) p0_prologue(F); REP_END(0) } SEAM(0);
    PH(1) { REP_BEGIN(1) p_router_fold(F); p_norm1_first(F); REP_END(1) } SEAM(1);
    for (int l = 0; l < DEPTH; ++l) {
        const int pb = 2 + 7 * l;
        const bool lastl = (l == DEPTH - 1);
        const int nrows = lastl ? TL : MT;
        PH(pb + 0) {
            REP_BEGIN(2)
            pg8::DenseSched<2> Sd; Sd.init(MT, INC, D, F.G, F.bx);
            pg8::EpiWin E{(bf16_t*)(F.ws + WS_P), (bf16_t*)(F.ws + WS_KF), (bf16_t*)(F.ws + WS_VF), (const float*)(F.ws + WS_ROPE), (const float*)(F.ws + WS_ROPE) + 320 * 16};
            pg8::gemm_phase<pg8::EpiWin, pg8::DenseSched<2>, true, 1>(F.lds, (const bf16_t*)(F.ws + WS_H), (const bf16_t*)(F.ws + WS_WIN) + (size_t)l * INC * D, D, Sd, E);
            REP_END(2)
        }
        SEAM(pb + 0);
        PH(pb + 1) {
            REP_BEGIN(3)
            p_mixers(F, l, nrows);
            REP_END(3)
        }
        SEAM(pb + 1);
        PH(pb + 2) {
            pg8::EpiWout E{(bf16_t*)(F.ws + WS_DX), (const float*)(F.ws + WS_MOD) + (size_t)l * 3 * 6144 + 2 * D};
            if constexpr (FP8_WOUT != 0) { pg8::DenseSched<1> Sd; Sd.init(nrows, D, MIXW, F.G, F.bx);
                pg8::gemm_phase<pg8::EpiWout, pg8::DenseSched<1>, true, 1, 1, true, false>(F.lds, F.ws + WS_MIX, F.ws + WS_WOUT + (size_t)l * D * MIXW, MIXW, Sd, E); }
            else { pg8::DenseSched<2> Sd; Sd.init(nrows, D, MIXW, F.G, F.bx);
                pg8::gemm_phase<pg8::EpiWout, pg8::DenseSched<2>, true, 1>(F.lds, (const bf16_t*)(F.ws + WS_MIX), (const bf16_t*)(F.ws + WS_WOUT) + (size_t)l * D * MIXW, MIXW, Sd, E); }
        }
        SEAM(pb + 2);
        PH(pb + 3) { p_router(F, l, nrows); p_convert_w1(F, l); }
        SEAM(pb + 3);
        PH(pb + 4) {
            REP_BEGIN(6)
            const int ntiles = moe_tables(F, l);
            constexpr int EB1 = FP8_MOE1 ? 1 : 2;
            pg8::MoeSched<true, EB1> Sm{(const LAS int*)(F.lds + TAB_TINFO), (const LAS int*)(F.lds + TAB_LCNT), (const int*)(F.ws + WS_SLOT_TOK), FF2 / 256, D * EB1, ntiles * (FF2 / 256), F.G, F.vcu, (unsigned)(FF2 * D * EB1)};
            pg8::EpiMoe1 E{(bf16_t*)(F.ws + WS_ACT), F.ka->in[I_B1] + (size_t)l * NE * FF2};
            pg8::gemm_phase<pg8::EpiMoe1, pg8::MoeSched<true, EB1>, true, (FP8_MOE1 ? SP2_FP8 : 1), EB1, (FP8_MOE1 != 0), false>(F.lds, F.ws + (FP8_MOE1 ? WS_H8 : WS_H), F.ws + WS_W1 + (size_t)l * NE * FF2 * D * EB1, D, Sm, E);
            p_convert_w2(F, l);
            REP_END(6)
        }
        SEAM(pb + 4);
        PH(pb + 5) {
            REP_BEGIN(7)
            const int ntiles = moe_tables(F, l);
            constexpr int EB2 = FP8_MOE2 ? 1 : 2;
            pg8::MoeSched<false, EB2, (FP8_MOE2 != 0)> Sm{(const LAS int*)(F.lds + TAB_TINFO), (const LAS int*)(F.lds + TAB_LCNT), nullptr, D / 256, FF * EB2, ntiles * (D / 256), F.G, F.vcu, (unsigned)(D * FF * EB2)};
            pg8::EpiMoe2 E{(bf16_t*)(F.ws + WS_Y), F.ka->in[I_B2] + (size_t)l * NE * D, (const int*)(F.ws + WS_SLOT_ASG), (const float*)(F.ws + WS_SLOT_GATE), (const LAS int*)(F.lds + TAB_LCNT)};
            pg8::gemm_phase<pg8::EpiMoe2, pg8::MoeSched<false, EB2, (FP8_MOE2 != 0)>, true, (FP8_MOE2 ? SP2_FP8 : 1), EB2, (FP8_MOE2 != 0), (FP8_MOE2 != 0)>(F.lds, F.ws + WS_ACT, F.ws + WS_W2 + (size_t)l * NE * D * FF * EB2, FF, Sm, E);
            REP_END(7)
        }
        SEAM(pb + 5);
        PH(pb + 6) { p_combine(F, l, nrows); }
        if (!lastl) SEAM(pb + 6);
    }
#undef IN
#undef SEAM
}

extern "C" void kernel_launch(void* const* d_in, const int* in_sizes, int n_in, void* d_out, int out_size, void* d_ws, size_t ws_size, hipStream_t stream) {
    static int grid = 0;
    if (grid == 0) {
        if (n_in != 25 || out_size != TL * D || ws_size < WS_END) { fprintf(stderr, "kernel_launch: unexpected problem (n_in %d, out %d, ws %zu)\n", n_in, out_size, ws_size); grid = -1; return; }
        int dev = 0, cus = 0, per_cu = 0;
        if (hipGetDevice(&dev) != hipSuccess || hipDeviceGetAttribute(&cus, hipDeviceAttributeMultiprocessorCount, dev) != hipSuccess) { grid = -1; return; }
        if (hipFuncSetAttribute((const void*)fwd_kernel, hipFuncAttributeMaxDynamicSharedMemorySize, LDS_BYTES) != hipSuccess) { fprintf(stderr, "kernel_launch: hipFuncSetAttribute failed\n"); grid = -1; return; }
        if (hipOccupancyMaxActiveBlocksPerMultiprocessor(&per_cu, (const void*)fwd_kernel, 512, LDS_BYTES) != hipSuccess || per_cu < 1) fprintf(stderr, "kernel_launch: occupancy query reports %d\n", per_cu);
        (void)hipGetLastError();
        grid = cus;
    }
    if (grid < 0) return;
    if (hipMemsetAsync((char*)d_ws + WS_CTL, 0, CTL_ZERO_BYTES, stream) != hipSuccess) return;
    Args a{};
    for (int i = 0; i < 25; ++i) a.in[i] = (const float*)d_in[i];
    a.out = (float*)d_out; a.ws = (unsigned char*)d_ws;
    constexpr int NL = MK_N_LAUNCHES;
    static_assert(NL == 1 || NL == NPHASES, "MK_N_LAUNCHES: 1 or one per phase");
    for (int li = 0; li < NL; ++li) {
        a.ph_lo = (NL == 1) ? 0 : li; a.ph_hi = (NL == 1) ? NPHASES : li + 1;
        hipLaunchKernelGGL(fwd_kernel, dim3(grid), dim3(512), LDS_BYTES, stream, a);
        if (hipPeekAtLastError() != hipSuccess) { fprintf(stderr, "kernel_launch: launch %d failed\n", li); break; }
    }
}
```

```cpp
#include <hip/hip_runtime.h>
#include <cstdio>
#include <cstdint>

#ifndef REPEAT_MASK
#define REPEAT_MASK 0x0
#endif
#ifndef FP8_MOE1
#define FP8_MOE1 1
#endif
#ifndef FP8_MOE2
#define FP8_MOE2 1
#endif
#ifndef FP8_IMG
#define FP8_IMG 0
#endif
#ifndef FP8_WOUT
#define FP8_WOUT 1
#endif
#ifndef ATTN_PAIR
#define ATTN_PAIR 1
#endif
#ifndef XL_BF16
#define XL_BF16 1
#endif
#ifndef W2_Q16
#define W2_Q16 1
#endif
#ifndef SK_FP8
#define SK_FP8 1
#endif
#ifndef SP2_FP8
#define SP2_FP8 1
#endif
#ifndef MK_N_LAUNCHES
#define MK_N_LAUNCHES 1
#endif

constexpr int D = 1024, NB = 2, S = 16384, LC = 256, DEPTH = 2;
constexpr int TL = NB * S, TC = NB * LC, MT = TL + TC;
constexpr int INC = 2304, MIXW = 1280, NE = 32, FF = 1024, FF2 = 2048;
constexpr int CAP = MT;
constexpr int MAXTILES = (MT * 4) / 256 + NE;
constexpr int NPHASES = 2 + 7 * DEPTH;
constexpr float EPS = 1e-6f;
constexpr float LOG2E = 1.4426950408889634f;
constexpr float QSCALE = 0.125f * LOG2E;
constexpr int PC_Q = 0, PC_K = 512, PC_V = 640, PC_SU = 768, PC_SV = 1024, PC_XP = 1280, PC_CB = 1536, PC_CC = 1792, PC_CX = 2048;

constexpr size_t MiB = 1u << 20;
constexpr size_t WS_CTL = 0, CTL_ZERO_BYTES = 1 * MiB;
constexpr size_t WS_MOD = 1 * MiB;
constexpr size_t WS_ROPE = 1 * MiB + 512 * 1024;
constexpr size_t WS_SLOT_TOK = 2 * MiB, WS_SLOT_ASG = 7 * MiB, WS_SLOT_GATE = 12 * MiB;
constexpr size_t WS_WIN = 17 * MiB;
constexpr size_t WS_WOUT = 26 * MiB;
constexpr size_t WS_W1 = 32 * MiB;
constexpr size_t WS_W2 = 288 * MiB;
constexpr size_t WS_XL = 416 * MiB;
constexpr size_t WS_H = 547 * MiB;
constexpr size_t WS_P = 613 * MiB;
constexpr size_t WS_MIX = 760 * MiB;
constexpr size_t WS_ACT = 842 * MiB;
constexpr size_t WS_Y = 1119 * MiB;
constexpr size_t WS_KF = 1380 * MiB;
constexpr size_t WS_VF = 1389 * MiB;
constexpr size_t WS_SGUW = 1398 * MiB;
constexpr size_t WS_POOLWT = 1399 * MiB;
constexpr size_t WS_RWP = 1400 * MiB;
constexpr size_t WS_BIASP = 1401 * MiB;
constexpr size_t WS_H8 = 1402 * MiB;
constexpr size_t WS_DX = 1436 * MiB;
constexpr size_t WS_END = 1502 * MiB;
constexpr int NT32 = MT / 32;
static_assert(WS_XL + (size_t)MT * D * 4 <= WS_H && WS_H + (size_t)MT * D * 2 <= WS_P && WS_P + (size_t)MT * INC * 2 <= WS_MIX && WS_MIX + (size_t)MT * MIXW * 2 <= WS_ACT &&
              WS_ACT + (size_t)MAXTILES * 256 * FF * 2 <= WS_Y && WS_Y + (size_t)MT * 4 * D * 2 <= WS_END && WS_SLOT_GATE + (size_t)NE * CAP * 4 <= WS_WIN, "d_ws map");
constexpr int CW_TMO = 0, CW_CODE = 1;
constexpr int CW_BAR = 4096;
constexpr int CW_CNT = 8192;

constexpr int RING_BYTES = 131072;
constexpr int LDS_BYTES = 163840;
constexpr int MISC_OFF = LDS_BYTES - 512;
constexpr int TAB_OFF = LDS_BYTES - 4096;
constexpr int TAB_LCNT = TAB_OFF + 160, TAB_TINFO = TAB_OFF + 288;
constexpr int SIDE_OFF = 131072, TOK_OFF = SIDE_OFF + 8192;

#define GAS __attribute__((address_space(1)))
#define LAS __attribute__((address_space(3)))
typedef unsigned short bf16_t;
typedef short bf16x8 __attribute__((ext_vector_type(8)));
typedef float f32x4 __attribute__((ext_vector_type(4)));
typedef float f32x2 __attribute__((ext_vector_type(2)));
typedef unsigned u32x4 __attribute__((ext_vector_type(4)));
typedef unsigned u32x2 __attribute__((ext_vector_type(2)));
#define LDS_WAIT() asm volatile("s_waitcnt lgkmcnt(0)" ::: "memory")
#define VM_WAIT() asm volatile("s_waitcnt vmcnt(0)" ::: "memory")

__device__ __forceinline__ unsigned cvt_pk_bf16(float lo, float hi) { unsigned r; asm volatile("v_cvt_pk_bf16_f32 %0, %1, %2" : "=v"(r) : "v"(lo), "v"(hi)); return r; }
__device__ __forceinline__ unsigned pk_fp8x4(float a0, float a1, float a2, float a3) { int p = __builtin_amdgcn_cvt_pk_fp8_f32(a0, a1, 0, false); p = __builtin_amdgcn_cvt_pk_fp8_f32(a2, a3, p, true); return (unsigned)p; }
constexpr float MIX8_SCALE = 4.0f;
__device__ __forceinline__ unsigned pk_mix8(float a0, float a1, float a2, float a3) {
    return pk_fp8x4(__builtin_amdgcn_fmed3f(a0 * MIX8_SCALE, -448.f, 448.f), __builtin_amdgcn_fmed3f(a1 * MIX8_SCALE, -448.f, 448.f), __builtin_amdgcn_fmed3f(a2 * MIX8_SCALE, -448.f, 448.f), __builtin_amdgcn_fmed3f(a3 * MIX8_SCALE, -448.f, 448.f)); }
constexpr float Y8_SCALE = 16.0f;
constexpr float W8_SCALE = 64.0f;
__device__ __forceinline__ float bf2f(unsigned short b) { return __uint_as_float(((unsigned)b) << 16); }
__device__ __forceinline__ float bflo(unsigned w) { return __uint_as_float(w << 16); }
__device__ __forceinline__ float bfhi(unsigned w) { return __uint_as_float(w & 0xffff0000u); }
__device__ __forceinline__ float wave_sum(float v) {
#pragma unroll
    for (int o = 1; o < 64; o <<= 1) v += __shfl_xor(v, o);
    return v;
}
__device__ __forceinline__ float gelu1(float v) {
    const float av = __builtin_fabsf(v), d = av * 0.2316418882f + 1.0f;
    const float t = __builtin_amdgcn_rcpf(d);
    float q = t * 0.5307027145f + (-0.7265760135f); q = q * t + 0.7107068705f; q = q * t + (-0.142248368f); q = q * t + 0.127414796f; q = q * t;
    const float s = (v * v) * (-0.72134752044f);
    const float e = __builtin_amdgcn_exp2f(s);
    const float m = v * (q * e), r = v - m;
    return v < 0.f ? m : r;
}

namespace pg8 {
constexpr int BM = 256, BK = 64, HALF = 128, HTB = HALF * BK * 2, STAGE_BYTES = 8 * HTB, NXCD = 8, WGM = 8;
__host__ __device__ __forceinline__ int lds_byte(int r, int c) { const int st = (r >> 4) * 2 + (c >> 5), rr = r & 15, cc = c & 31, ob = rr * 64 + cc * 2; return st * 1024 + (ob ^ (((ob >> 9) & 1) << 5)); }
__host__ __device__ __forceinline__ void stage_rc(int b, int& R, int& C) { const int st = b / 1024, sb = b % 1024, swz = sb ^ (((sb >> 9) & 1) << 5); R = (st >> 1) * 16 + swz / 64; C = (st & 1) * 32 + (swz % 64) / 2; }
__host__ __device__ __forceinline__ int perm32(int rho) { const int n = rho >> 4, i = rho & 15; return 8 * (i >> 2) + 4 * n + (i & 3); }

template <int IMM> __device__ __forceinline__ void glds16_s(const void* sbase, unsigned voff, unsigned lds_base) {
    unsigned keep;
    asm volatile("s_mov_b32 %0, m0\n\ts_add_i32 m0, %3, %4\n\ts_nop 0\n\tglobal_load_lds_dwordx4 %1, %2\n\ts_mov_b32 m0, %0" : "=&s"(keep) : "v"(voff), "s"(sbase), "s"(lds_base), "i"(IMM) : "memory", "scc");
}
__device__ __forceinline__ void glds16_fresh(const void* sbase, unsigned voff, unsigned lds_dst) {
    unsigned keep;
    asm volatile("s_nop 4\n\ts_mov_b32 %0, m0\n\ts_mov_b32 m0, %3\n\ts_nop 0\n\tglobal_load_lds_dwordx4 %1, %2\n\ts_mov_b32 m0, %0" : "=&s"(keep) : "v"(voff), "s"(sbase), "s"(lds_dst) : "memory");
}
typedef int v8i __attribute__((ext_vector_type(8)));
typedef int v4i __attribute__((ext_vector_type(4)));
__device__ __forceinline__ v8i frag8(bf16x8 lo, bf16x8 hi) { return __builtin_shufflevector(__builtin_bit_cast(v4i, lo), __builtin_bit_cast(v4i, hi), 0, 1, 2, 3, 4, 5, 6, 7); }
template <class T> __device__ __forceinline__ T* uni_ptr(T* p) { const unsigned long long a = (unsigned long long)(uintptr_t)p; const unsigned lo = (unsigned)__builtin_amdgcn_readfirstlane((int)a), hi = (unsigned)__builtin_amdgcn_readfirstlane((int)(a >> 32)); return (T*)(uintptr_t)(((unsigned long long)hi << 32) | lo); }
#define GAS __attribute__((address_space(1)))
typedef long long i64x2z __attribute__((ext_vector_type(2)));
struct Unit { int pm, pn, e, mt; };

template <int EB> __device__ __forceinline__ void stage_src(int b, int& R, int& CB) {
    if constexpr (EB == 2 || !FP8_IMG) { int C; stage_rc(b, R, C); CB = C * 2; }
    else { const int f = (b >> 4) & 63; R = (b >> 10) * 8 + (f & 7); CB = (((f >> 5) & 1) * 4 + ((f >> 3) & 1) * 2 + ((f >> 4) & 1)) * 16; }
}
template <int EB> struct DenseSched {
    int nM, nN, nwg, G, c, rowb;
    __device__ void init(int M, int N, int K_, int G_, int c_) { nM = M / BM; nN = N / BM; nwg = nM * nN; G = G_; c = c_; rowb = K_ * EB; }
    __device__ __forceinline__ bool next(int i, Unit& u) const {
        const long L = (long)i * G + c; if (L >= nwg) return false;
        int wgid = (int)L; { const int q = nwg / NXCD, r = nwg % NXCD, xcd = wgid % NXCD, off = wgid / NXCD; wgid = (xcd < r ? xcd * (q + 1) : r * (q + 1) + (xcd - r) * q) + off; }
        const int nig = WGM * nN, gid = wgid / nig, fm = gid * WGM, gsz = (nM - fm) < WGM ? (nM - fm) : WGM;
        u.pm = fm + ((wgid % nig) % gsz); u.pn = (wgid % nig) / gsz; u.e = 0; u.mt = 0; return true;
    }
    __device__ __forceinline__ void a_off(const Unit& u, int tid, unsigned (&off)[2][2]) const {
#pragma unroll
        for (int i = 0; i < 2; ++i) { int R, CB; stage_src<EB>(tid * 16 + i * 8192, R, CB);
#pragma unroll
            for (int h = 0; h < 2; ++h) off[h][i] = (unsigned)((u.pm * BM + h * HALF + R) * rowb + CB); }
    }
    __device__ __forceinline__ unsigned b_off(const Unit& u) const { return (unsigned)(u.pn * BM * rowb); }
    static constexpr bool TOKSIDE = false;
    __device__ __forceinline__ const char* tok_src(const Unit&) const { return nullptr; }
    __device__ __forceinline__ void a_off_lds(const Unit&, int, unsigned (&)[2][2], const LAS int*) const {}
};
template <bool GATHER, int EB, bool ATILE = false> struct MoeSched {
    const LAS int* tinfo; const LAS int* lcnt; const int* slot_tok; int nN, rowb, nunits, G, vcu; unsigned bstride;
    __device__ __forceinline__ bool next(int i, Unit& u) const {
        const int L = i * G + vcu; if (L >= nunits) return false;
        const int T = L / nN; u.pm = T; u.pn = L - T * nN;
        const int ti = __builtin_amdgcn_readfirstlane(tinfo[T]);
        u.e = ti & 255; u.mt = ti >> 8; return true;
    }
    __device__ __forceinline__ void a_off(const Unit& u, int tid, unsigned (&off)[2][2]) const {
        const int n = GATHER ? __builtin_amdgcn_readfirstlane(lcnt[u.e]) : 0;
#pragma unroll
        for (int i = 0; i < 2; ++i) { int R, CB; stage_src<EB>(tid * 16 + i * 8192, R, CB);
#pragma unroll
            for (int h = 0; h < 2; ++h) {
                if constexpr (GATHER) { const int pos = u.mt * BM + h * HALF + R; const int row = slot_tok[u.e * CAP + (pos < n ? pos : 0)]; off[h][i] = (unsigned)((pos < n ? row : 0) * rowb + CB); }
                else off[h][i] = ATILE ? (unsigned)(u.pm * BM * rowb + (h * HALF + R) * 128 + CB) : (unsigned)((u.pm * BM + h * HALF + R) * rowb + CB); } }
    }
    __device__ __forceinline__ unsigned b_off(const Unit& u) const { return (unsigned)u.e * bstride + (unsigned)(u.pn * BM * rowb); }
    static constexpr bool TOKSIDE = GATHER && (EB == 1);
    __device__ __forceinline__ const char* tok_src(const Unit& u) const { return (const char*)(slot_tok + (size_t)u.e * CAP + (size_t)u.mt * BM); }
    __device__ __forceinline__ void a_off_lds(const Unit& u, int tid, unsigned (&off)[2][2], const LAS int* tok) const {
        const int n = __builtin_amdgcn_readfirstlane(lcnt[u.e]);
#pragma unroll
        for (int i = 0; i < 2; ++i) { int R, CB; stage_src<EB>(tid * 16 + i * 8192, R, CB);
#pragma unroll
            for (int h = 0; h < 2; ++h) { const int pos = u.mt * BM + h * HALF + R; const int row = tok[h * HALF + R]; off[h][i] = (unsigned)((pos < n ? row : 0) * rowb + CB); } }
    }
};

template <class Epi, class Sched, bool ALIGN_EPI, int SP2, int EB = 2, bool BTILED = false, bool ATILED = false>
__device__ __forceinline__ void gemm_phase(LAS unsigned char* lds, const void* Aptr, const void* Btptr, int K, const Sched& S, const Epi& E) {
    int tid = threadIdx.x; asm volatile("" : "+v"(tid));
    const int wid = __builtin_amdgcn_readfirstlane(tid >> 6), lane = tid & 63, wr = wid >> 2, wc = wid & 3, fr = lane & 15, fq = lane >> 4;
    const int rowb = K * EB, nt = rowb / 128;
    unsigned voffB[2];
#pragma unroll
    for (int i = 0; i < 2; ++i) { int R, CB; stage_src<EB>(tid * 16 + i * 8192, R, CB); voffB[i] = (unsigned)(R * (BTILED ? 128 : rowb) + CB); }
    const unsigned kstep = ATILED ? 256u * 128u : 128u;
    const unsigned hstep = (unsigned)(HALF * rowb);
    const unsigned kstepB = BTILED ? 256u * 128u : 128u, hstepB = BTILED ? (unsigned)(HALF * 128) : hstep;
    const unsigned ldsb = (unsigned)(uintptr_t)lds + (unsigned)wid * 1024u;
    const int l8 = (fr >> 3) * 1024 + (fr & 7) * 16 + (fq & 1) * 128 + (fq >> 1) * 512;
    constexpr bool IMG16 = (EB == 2) || !FP8_IMG;
    const int aoff = IMG16 ? lds_byte(wr * 64 + fr, fq * 8) : wr * 8192 + l8, boff = IMG16 ? lds_byte(wc * 32 + fr, fq * 8) : wc * 4096 + l8;
    constexpr int FSTEP = IMG16 ? 1024 : 256;
    constexpr bool SK = (EB == 1) && (SK_FP8 != 0);
    const char* Ab; const char* Bb;
    { const unsigned long long a_ = (unsigned long long)(uintptr_t)Aptr, b_ = (unsigned long long)(uintptr_t)Btptr;
      Ab = (const char*)(uintptr_t)(((unsigned long long)(unsigned)__builtin_amdgcn_readfirstlane((int)(a_ >> 32)) << 32) | (unsigned)__builtin_amdgcn_readfirstlane((int)a_));
      Bb = (const char*)(uintptr_t)(((unsigned long long)(unsigned)__builtin_amdgcn_readfirstlane((int)(b_ >> 32)) << 32) | (unsigned)__builtin_amdgcn_readfirstlane((int)b_)); }
#define PG8_SA(b, h) (((b) * 2 + (h)) * HTB)
#define PG8_SB(b, h) ((4 + (b) * 2 + (h)) * HTB)
#define PG8_STAGE_B(bufoff, sb) do { if constexpr (SK) { const char* p_ = Bb + (sb); glds16_s<(bufoff)>(p_, voffB[0], ldsb); glds16_s<(bufoff) + 8192>(p_, voffB[1], ldsb); } \
        else { glds16_s<(bufoff)>(Bb, voffB[0] + (sb), ldsb); glds16_s<(bufoff) + 8192>(Bb, voffB[1] + (sb), ldsb); } } while (0)
#define PG8_STAGE_A(bufoff, o0, o1, kb) do { if constexpr (SK) { const char* p_ = Ab + (kb); glds16_s<(bufoff)>(p_, (o0), ldsb); glds16_s<(bufoff) + 8192>(p_, (o1), ldsb); } \
        else { glds16_s<(bufoff)>(Ab, (o0) + (kb), ldsb); glds16_s<(bufoff) + 8192>(Ab, (o1) + (kb), ldsb); } } while (0)
#define PG8_LDA(dst, b, h) do { _Pragma("unroll") for (int m = 0; m < 4; ++m) _Pragma("unroll") for (int k = 0; k < 2; ++k) dst[m][k] = *(const LAS bf16x8*)(lds + PG8_SA(b, h) + aoff + m * 2048 + k * FSTEP); } while (0)
#define PG8_LDB(dst, b, h) do { _Pragma("unroll") for (int n = 0; n < 2; ++n) _Pragma("unroll") for (int k = 0; k < 2; ++k) dst[n][k] = *(const LAS bf16x8*)(lds + PG8_SB(b, h) + boff + n * 2048 + k * FSTEP); } while (0)
#define PG8_MMA(ai, bj, At, Bt) do { __builtin_amdgcn_s_setprio(1); _Pragma("unroll") for (int m = 0; m < 4; ++m) _Pragma("unroll") for (int n = 0; n < 2; ++n) { \
        if constexpr (EB == 2) { _Pragma("unroll") for (int k = 0; k < 2; ++k) acc[ai][bj][m][n] = __builtin_amdgcn_mfma_f32_16x16x32_bf16(Bt[n][k], At[m][k], acc[ai][bj][m][n], 0, 0, 0); } \
        else acc[ai][bj][m][n] = __builtin_amdgcn_mfma_scale_f32_16x16x128_f8f6f4(frag8(Bt[n][0], Bt[n][1]), frag8(At[m][0], At[m][1]), acc[ai][bj][m][n], 0, 0, 0, 0x7f7f7f7f, 0, 0x7f7f7f7f); } \
        __builtin_amdgcn_s_setprio(0); } while (0)
#define PG8_MMA_H(ai, bj, At, Bt, mh) do { _Pragma("unroll") for (int m = 2 * (mh); m < 2 * (mh) + 2; ++m) _Pragma("unroll") for (int n = 0; n < 2; ++n) { \
        if constexpr (EB == 2) { _Pragma("unroll") for (int k = 0; k < 2; ++k) acc[ai][bj][m][n] = __builtin_amdgcn_mfma_f32_16x16x32_bf16(Bt[n][k], At[m][k], acc[ai][bj][m][n], 0, 0, 0); } \
        else acc[ai][bj][m][n] = __builtin_amdgcn_mfma_scale_f32_16x16x128_f8f6f4(frag8(Bt[n][0], Bt[n][1]), frag8(At[m][0], At[m][1]), acc[ai][bj][m][n], 0, 0, 0, 0x7f7f7f7f, 0, 0x7f7f7f7f); } } while (0)
#define PG8_BLOCK(ai, D0, D1, D2) do { __builtin_amdgcn_s_setprio(1); PG8_MMA_H(ai, 0, At, B0, 0); PG8_SCHED; D0; PG8_SCHED; PG8_MMA_H(ai, 0, At, B0, 1); PG8_SCHED; D1; PG8_SCHED; \
        PG8_MMA_H(ai, 1, At, B1, 0); PG8_SCHED; D2; PG8_SCHED; PG8_MMA_H(ai, 1, At, B1, 1); __builtin_amdgcn_s_setprio(0); } while (0)
#define PG8_NOP do { } while (0)
#define PG8_NEXT_A do { if (last && has_next) { Unit n_ = nxt; int t_ = tid; asm volatile("" : "+s"(n_.pm), "+s"(n_.e), "+s"(n_.mt), "+v"(t_)); \
        if constexpr (Sched::TOKSIDE) S.a_off_lds(n_, t_, offC, (const LAS int*)(lds + TOK_OFF + ((ui + 1) & 1) * 1024)); else S.a_off(n_, t_, offC); } } while (0)
#define PG8_WAIT_V(n) asm volatile("s_waitcnt vmcnt(" #n ")" ::: "memory")
#define PG8_WAIT_L(n) asm volatile("s_waitcnt lgkmcnt(" #n ")" ::: "memory")
#define PG8_BAR __builtin_amdgcn_s_barrier()
#define PG8_SCHED __builtin_amdgcn_sched_barrier(0)
    Unit cur, nxt; int ui = 0;
    if (!S.next(0, cur)) return;
    f32x4 acc[2][2][4][2];
#pragma unroll
    for (int a = 0; a < 2; ++a)
#pragma unroll
        for (int b = 0; b < 2; ++b)
#pragma unroll
            for (int m = 0; m < 4; ++m)
#pragma unroll
                for (int n = 0; n < 2; ++n) { i64x2z z_; asm volatile("v_mov_b64 %0, 0" : "=v"(z_.x)); asm volatile("v_mov_b64 %0, 0" : "=v"(z_.y)); acc[a][b][m][n] = __builtin_bit_cast(f32x4, z_); }
    bf16x8 At[4][2], B0[2][2], B1[2][2];
    unsigned offC[2][2];
    S.a_off(cur, tid, offC);
    unsigned cB = S.b_off(cur);
    if constexpr (SP2 != 0) {
        PG8_STAGE_B(PG8_SB(0, 0), cB); PG8_STAGE_B(PG8_SB(0, 1), cB + hstepB); PG8_STAGE_A(PG8_SA(0, 0), offC[0][0], offC[0][1], 0u); PG8_STAGE_A(PG8_SA(0, 1), offC[1][0], offC[1][1], 0u);
        if (wr == 1) PG8_BAR;
        PG8_WAIT_V(2); PG8_BAR;
        PG8_STAGE_B(PG8_SB(1, 0), cB + kstepB); PG8_STAGE_A(PG8_SA(1, 0), offC[0][0], offC[0][1], kstep); PG8_STAGE_B(PG8_SB(1, 1), cB + hstepB + kstepB);
        PG8_WAIT_V(6); PG8_BAR;
    } else {
        PG8_STAGE_B(PG8_SB(0, 0), cB); PG8_STAGE_A(PG8_SA(0, 0), offC[0][0], offC[0][1], 0u); PG8_STAGE_B(PG8_SB(0, 1), cB + hstepB); PG8_STAGE_A(PG8_SA(0, 1), offC[1][0], offC[1][1], 0u);
        if (wr == 1) PG8_BAR;
        PG8_WAIT_V(4); PG8_BAR;
        PG8_STAGE_B(PG8_SB(1, 0), cB + kstepB); PG8_STAGE_A(PG8_SA(1, 0), offC[0][0], offC[0][1], kstep); PG8_STAGE_B(PG8_SB(1, 1), cB + hstepB + kstepB);
        PG8_WAIT_V(6); PG8_BAR;
    }
    for (;;) {
        const bool has_next = S.next(ui + 1, nxt);
        const unsigned nB = has_next ? S.b_off(nxt) : cB;
        if constexpr (Epi::NSIDE > 0) { if (wid < Epi::NSIDE) glds16_fresh(uni_ptr(E.side_src(cur, wid)), (unsigned)lane * 16u, (unsigned)(uintptr_t)lds + (unsigned)(SIDE_OFF + (ui & 1) * 4096) + (unsigned)wid * 1024u); }
        if constexpr (Sched::TOKSIDE) { if (wid == 4 && has_next) glds16_fresh(uni_ptr(S.tok_src(nxt)), (unsigned)lane * 16u, (unsigned)(uintptr_t)lds + (unsigned)(TOK_OFF + ((ui + 1) & 1) * 1024)); }
        for (int t = 0; t < nt; t += 2) {
            const bool last = (t == nt - 2);
            const unsigned k1 = (unsigned)(t + 1) * kstep;
            const unsigned k2 = last ? 0u : (unsigned)(t + 2) * kstep, k3 = k2 + kstep;
            const unsigned b2 = last ? nB : cB + (unsigned)(t + 2) * kstepB, b3 = b2 + kstepB;
            if constexpr (SP2 == 2) {
            PG8_LDB(B0, 0, 0); PG8_LDB(B1, 0, 1); PG8_SCHED; PG8_LDA(At, 0, 0);
            PG8_WAIT_V(6); PG8_WAIT_L(0); PG8_BAR;
            PG8_BLOCK(0, PG8_STAGE_A(PG8_SA(1, 1), offC[1][0], offC[1][1], k1), PG8_NOP, PG8_NOP); PG8_BAR; PG8_SCHED;
            PG8_LDA(At, 0, 1);
            PG8_NEXT_A;
            PG8_WAIT_V(2); PG8_WAIT_L(0); PG8_BAR;
            PG8_BLOCK(1, PG8_STAGE_B(PG8_SB(0, 0), b2), PG8_STAGE_B(PG8_SB(0, 1), b2 + hstepB), PG8_STAGE_A(PG8_SA(0, 0), offC[0][0], offC[0][1], k2)); PG8_BAR; PG8_SCHED;
            PG8_LDB(B0, 1, 0); PG8_LDB(B1, 1, 1); PG8_SCHED; PG8_LDA(At, 1, 0);
            PG8_WAIT_V(6); PG8_WAIT_L(0); PG8_BAR;
            PG8_BLOCK(0, PG8_STAGE_A(PG8_SA(0, 1), offC[1][0], offC[1][1], k2), PG8_NOP, PG8_NOP); PG8_BAR; PG8_SCHED;
            PG8_LDA(At, 1, 1);
            PG8_WAIT_V(2); PG8_WAIT_L(0); PG8_BAR;
            PG8_BLOCK(1, PG8_STAGE_B(PG8_SB(1, 0), b3), PG8_STAGE_B(PG8_SB(1, 1), b3 + hstepB), PG8_STAGE_A(PG8_SA(1, 0), offC[0][0], offC[0][1], k3)); PG8_BAR; PG8_SCHED;
            } else if constexpr (SP2 == 1) {
            PG8_LDB(B0, 0, 0); PG8_LDB(B1, 0, 1); PG8_SCHED; PG8_LDA(At, 0, 0); PG8_STAGE_A(PG8_SA(1, 1), offC[1][0], offC[1][1], k1);
            PG8_NEXT_A;
            PG8_WAIT_V(8); PG8_WAIT_L(0); PG8_BAR; PG8_MMA(0, 0, At, B0); PG8_MMA(0, 1, At, B1); PG8_BAR; PG8_SCHED;
            PG8_LDA(At, 0, 1); PG8_STAGE_B(PG8_SB(0, 0), b2); PG8_STAGE_B(PG8_SB(0, 1), b2 + hstepB); PG8_STAGE_A(PG8_SA(0, 0), offC[0][0], offC[0][1], k2);
            PG8_WAIT_V(8); PG8_WAIT_L(0); PG8_BAR; PG8_MMA(1, 0, At, B0); PG8_MMA(1, 1, At, B1); PG8_BAR; PG8_SCHED;
            PG8_LDB(B0, 1, 0); PG8_LDB(B1, 1, 1); PG8_SCHED; PG8_LDA(At, 1, 0); PG8_STAGE_A(PG8_SA(0, 1), offC[1][0], offC[1][1], k2);
            PG8_WAIT_V(8); PG8_WAIT_L(0); PG8_BAR; PG8_MMA(0, 0, At, B0); PG8_MMA(0, 1, At, B1); PG8_BAR; PG8_SCHED;
            PG8_LDA(At, 1, 1); PG8_STAGE_B(PG8_SB(1, 0), b3); PG8_STAGE_B(PG8_SB(1, 1), b3 + hstepB); PG8_STAGE_A(PG8_SA(1, 0), offC[0][0], offC[0][1], k3);
            PG8_WAIT_V(8); PG8_WAIT_L(0); PG8_BAR; PG8_MMA(1, 0, At, B0); PG8_MMA(1, 1, At, B1); PG8_BAR; PG8_SCHED;
            } else {
            PG8_LDB(B0, 0, 0); PG8_SCHED; PG8_LDA(At, 0, 0); PG8_STAGE_A(PG8_SA(1, 1), offC[1][0], offC[1][1], k1);
            PG8_NEXT_A;
            PG8_WAIT_L(8); PG8_BAR; PG8_WAIT_L(0); PG8_MMA(0, 0, At, B0); PG8_BAR; PG8_SCHED;
            PG8_LDB(B1, 0, 1); PG8_STAGE_B(PG8_SB(0, 0), b2);
            PG8_BAR; PG8_WAIT_L(0); PG8_MMA(0, 1, At, B1); PG8_BAR;
            PG8_LDA(At, 0, 1); PG8_STAGE_A(PG8_SA(0, 0), offC[0][0], offC[0][1], k2);
            PG8_BAR; PG8_WAIT_L(0); PG8_MMA(1, 0, At, B0); PG8_BAR; PG8_SCHED;
            PG8_STAGE_B(PG8_SB(0, 1), b2 + hstepB);
            PG8_WAIT_V(6); PG8_BAR; PG8_MMA(1, 1, At, B1); PG8_BAR;
            PG8_LDB(B0, 1, 0); PG8_SCHED; PG8_LDA(At, 1, 0); PG8_STAGE_A(PG8_SA(0, 1), offC[1][0], offC[1][1], k2);
            PG8_WAIT_L(8); PG8_BAR; PG8_WAIT_L(0); PG8_MMA(0, 0, At, B0); PG8_BAR; PG8_SCHED;
            PG8_LDB(B1, 1, 1); PG8_STAGE_B(PG8_SB(1, 0), b3);
            PG8_BAR; PG8_WAIT_L(0); PG8_MMA(0, 1, At, B1); PG8_BAR;
            PG8_LDA(At, 1, 1); PG8_STAGE_A(PG8_SA(1, 0), offC[0][0], offC[0][1], k3);
            PG8_BAR; PG8_WAIT_L(0); PG8_MMA(1, 0, At, B0); PG8_BAR; PG8_SCHED;
            PG8_STAGE_B(PG8_SB(1, 1), b3 + hstepB);
            PG8_WAIT_V(6); PG8_BAR; PG8_MMA(1, 1, At, B1); PG8_BAR;
            }
        }
        if constexpr (ALIGN_EPI) { if (wr == 0) PG8_BAR; }
        { Unit ue_ = cur; int fr_ = fr, fq_ = fq, wr_ = wr, wc_ = wc;
          if constexpr (EB == 1) asm volatile("" : "+s"(ue_.pm), "+s"(ue_.pn), "+s"(ue_.e), "+s"(ue_.mt), "+v"(fr_), "+v"(fq_), "+s"(wr_), "+s"(wc_));
          if constexpr (EB == 1) { Epi Ee_ = E; Ee_.opaque(); for (int er_ = 0; er_ < Epi::REP; ++er_) Ee_(acc, ue_, wr_, wc_, fr_, fq_, lds + SIDE_OFF + (ui & 1) * 4096); }
          else for (int er_ = 0; er_ < Epi::REP; ++er_) E(acc, ue_, wr_, wc_, fr_, fq_); }
        if (!has_next) break;
#pragma unroll
        for (int a = 0; a < 2; ++a)
#pragma unroll
            for (int b = 0; b < 2; ++b)
#pragma unroll
                for (int m = 0; m < 4; ++m)
#pragma unroll
                    for (int n = 0; n < 2; ++n) { i64x2z z_; asm volatile("v_mov_b64 %0, 0" : "=v"(z_.x)); asm volatile("v_mov_b64 %0, 0" : "=v"(z_.y)); acc[a][b][m][n] = __builtin_bit_cast(f32x4, z_); }
        cur = nxt; cB = nB; ++ui;
        if constexpr (ALIGN_EPI) { if (wr == 1) PG8_BAR; }
    }
    PG8_WAIT_V(0);
    if constexpr (!ALIGN_EPI) { if (wr == 0) PG8_BAR; }
    PG8_BAR;
#undef PG8_SA
#undef PG8_SB
#undef PG8_STAGE_B
#undef PG8_STAGE_A
#undef PG8_LDA
#undef PG8_LDB
#undef PG8_MMA
#undef PG8_MMA_H
#undef PG8_BLOCK
#undef PG8_NOP
#undef PG8_NEXT_A
#undef PG8_WAIT_V
#undef PG8_WAIT_L
#undef PG8_BAR
#undef PG8_SCHED
}

struct EpiWin {
    static constexpr int NSIDE = 0;
#ifndef REP_EPIWIN
#define REP_EPIWIN 1
#endif
    static constexpr int REP = REP_EPIWIN;
    bf16_t* P; bf16_t* KF; bf16_t* VF; const float* cosT; const float* sinT;
    __device__ __forceinline__ void operator()(const f32x4 (&acc)[2][2][4][2], const Unit& u, int wr, int wc, int fr, int fq) const {
        const int row0 = u.pm * BM + wr * 64 + fr, colt = u.pn * BM + wc * 64 + fq * 8;
        const int mode = (u.pn < 2) ? 0 : (u.pn == 2 ? (wc < 2 ? 1 : 4) : (u.pn <= 4 ? 3 : 2));
        const bool rope = (mode <= 1) && (u.pm < TL / BM);
#pragma unroll
        for (int ai = 0; ai < 2; ++ai)
#pragma unroll
            for (int m = 0; m < 4; ++m) {
                const int r = row0 + ai * HALF + m * 16;
                f32x4 v[2][2];
#pragma unroll
                for (int bj = 0; bj < 2; ++bj)
#pragma unroll
                    for (int n = 0; n < 2; ++n) v[bj][n] = acc[ai][bj][m][n];
                if (rope) {
                    const int t = r & (S - 1); const int idx = (fq < 2) ? (t >> 6) : 256 + (t & 63); const int tb = idx * 16 + (fq & 1) * 8;
                    f32x4 cs[2], sn[2];
                    cs[0] = *(const f32x4*)(cosT + tb); cs[1] = *(const f32x4*)(cosT + tb + 4); sn[0] = *(const f32x4*)(sinT + tb); sn[1] = *(const f32x4*)(sinT + tb + 4);
#pragma unroll
                    for (int n = 0; n < 2; ++n) { const f32x4 x1 = v[0][n], x2 = v[1][n]; v[0][n] = x1 * cs[n] - x2 * sn[n]; v[1][n] = x1 * sn[n] + x2 * cs[n]; }
                }
                if (mode == 0) {
#pragma unroll
                    for (int bj = 0; bj < 2; ++bj)
#pragma unroll
                        for (int n = 0; n < 2; ++n) v[bj][n] = v[bj][n] * QSCALE;
                }
                if (mode == 3) {
#pragma unroll
                    for (int bj = 0; bj < 2; ++bj)
#pragma unroll
                        for (int n = 0; n < 2; ++n)
#pragma unroll
                            for (int g = 0; g < 4; ++g) v[bj][n][g] = gelu1(v[bj][n][g]);
                }
                if (mode == 4) {
                    const int t32 = r & 31, ko = t32 & 15;
                    bf16_t* vb = VF + (size_t)((wc - 2) * NT32 + (r >> 5)) * 2048 + ((t32 >> 4) * 2 + ((ko >> 2) & 1)) * 256 + 4 * ((ko >> 3) & 1) + (ko & 3) + fq * 64;
#pragma unroll
                    for (int bj = 0; bj < 2; ++bj)
#pragma unroll
                        for (int n = 0; n < 2; ++n) { const unsigned w0 = cvt_pk_bf16(v[bj][n][0], v[bj][n][1]), w1 = cvt_pk_bf16(v[bj][n][2], v[bj][n][3]);
                            bf16_t* p = vb + bj * 1024 + n * 32;
                            p[0] = (bf16_t)(w0 & 0xffffu); p[8] = (bf16_t)(w0 >> 16); p[16] = (bf16_t)(w1 & 0xffffu); p[24] = (bf16_t)(w1 >> 16); }
                } else {
                    bf16_t* rowp = (mode == 1) ? KF + (size_t)(wc * NT32 + (r >> 5)) * 2048 + (r & 31) * 8 + (fq >> 1) * 512 + (fq & 1) * 256
                                               : P + (size_t)r * INC + colt;
                    const int bstep = (mode == 1) ? 1024 : 32;
#pragma unroll
                    for (int bj = 0; bj < 2; ++bj) { u32x4 w; w.x = cvt_pk_bf16(v[bj][0][0], v[bj][0][1]); w.y = cvt_pk_bf16(v[bj][0][2], v[bj][0][3]); w.z = cvt_pk_bf16(v[bj][1][0], v[bj][1][1]); w.w = cvt_pk_bf16(v[bj][1][2], v[bj][1][3]);
                        *(u32x4*)(rowp + bj * bstep) = w; }
                }
            }
    }
};
struct EpiWout {
    static constexpr int NSIDE = 0;
#ifndef REP_EPIWOUT
#define REP_EPIWOUT 1
#endif
    static constexpr int REP = REP_EPIWOUT;
    bf16_t* DX; const float* g1;
    __device__ __forceinline__ void opaque() { DX = uni_ptr(DX); g1 = uni_ptr(g1); asm volatile("" : "+s"(DX), "+s"(g1)); }
    __device__ __forceinline__ const char* side_src(const Unit&, int) const { return nullptr; }
    __device__ __forceinline__ void operator()(const f32x4 (&acc)[2][2][4][2], const Unit& u, int wr, int wc, int fr, int fq, const LAS unsigned char*) const { (*this)(acc, u, wr, wc, fr, fq); }
    __device__ __forceinline__ void operator()(const f32x4 (&acc)[2][2][4][2], const Unit& u, int wr, int wc, int fr, int fq) const {
        const int row0 = u.pm * BM + wr * 64 + fr, c0 = u.pn * BM + wc * 32 + fq * 8;
        const int midx = (u.pm < TL / BM) ? (u.pm >> 6) : 2;
        f32x4 gv[2][2];
#pragma unroll
        for (int bj = 0; bj < 2; ++bj)
#pragma unroll
            for (int n = 0; n < 2; ++n) gv[bj][n] = *(const GAS f32x4*)(g1 + midx * 6144 + c0 + bj * HALF + 4 * n) * (FP8_WOUT ? 1.0f / (W8_SCALE * MIX8_SCALE) : 1.0f);
#pragma unroll
        for (int ai = 0; ai < 2; ++ai)
#pragma unroll
            for (int m = 0; m < 4; ++m) { bf16_t* rowp = DX + (size_t)(row0 + ai * HALF + m * 16) * D + c0;
#pragma unroll
                for (int bj = 0; bj < 2; ++bj) { const f32x4 v0 = acc[ai][bj][m][0] * gv[bj][0], v1 = acc[ai][bj][m][1] * gv[bj][1];
                    u32x4 w; w.x = cvt_pk_bf16(v0[0], v0[1]); w.y = cvt_pk_bf16(v0[2], v0[3]); w.z = cvt_pk_bf16(v1[0], v1[1]); w.w = cvt_pk_bf16(v1[2], v1[3]);
                    *(GAS u32x4*)(rowp + bj * HALF) = w; } }
    }
};
struct EpiMoe1 {
#ifndef REP_EPIMOE1
#define REP_EPIMOE1 1
#endif
    static constexpr int REP = REP_EPIMOE1;
    bf16_t* ACT; const float* b1;
    __device__ __forceinline__ void opaque() { ACT = uni_ptr(ACT); b1 = uni_ptr(b1); asm volatile("" : "+s"(ACT), "+s"(b1)); }
    static constexpr int NSIDE = 1;
    __device__ __forceinline__ const char* side_src(const Unit& u, int) const { return (const char*)(b1 + (size_t)u.e * FF2 + (size_t)u.pn * 256); }
    __device__ __forceinline__ void operator()(const f32x4 (&acc)[2][2][4][2], const Unit& u, int wr, int wc, int fr, int fq, const LAS unsigned char* side) const {
        const int row0 = u.pm * BM + wr * 64 + fr, f0 = u.pn * 128 + wc * 32 + fq * 8;
        f32x4 bb[4];
#pragma unroll
        for (int q = 0; q < 4; ++q) bb[q] = *(const LAS f32x4*)(side + (2 * (wc * 32 + fq * 8) + 4 * q) * 4);
        constexpr float WS1 = FP8_MOE1 ? 1.0f / W8_SCALE : 1.0f;
        constexpr float CG = -1.702f * LOG2E;
        float bgc[8], blc[8];
#pragma unroll
        for (int n = 0; n < 2; ++n)
#pragma unroll
            for (int g = 0; g < 4; ++g) { bgc[4 * n + g] = bb[2 * n + (g >> 1)][2 * (g & 1)] * CG; blc[4 * n + g] = (bb[2 * n + (g >> 1)][2 * (g & 1) + 1] + 1.0f) * (1.0f / CG); }
#pragma unroll
        for (int ai = 0; ai < 2; ++ai)
#pragma unroll
            for (int m = 0; m < 4; ++m) { float a[8];
#pragma unroll
                for (int n = 0; n < 2; ++n)
#pragma unroll
                    for (int g = 0; g < 4; ++g) {
                        const float gs = __builtin_fmaxf(__builtin_fmaf(acc[ai][0][m][n][g], WS1 * CG, bgc[4 * n + g]), 7.0f * CG);
                        const float lc = __builtin_amdgcn_fmed3f(__builtin_fmaf(acc[ai][1][m][n][g], WS1 / CG, blc[4 * n + g]), 8.0f / CG, -6.0f / CG);
                        const float sg = __builtin_amdgcn_rcpf(1.0f + __builtin_amdgcn_exp2f(gs));
                        a[4 * n + g] = (gs * sg) * lc;
                    }
                if constexpr (FP8_MOE2) { u32x2 w; w.x = pk_fp8x4(a[0], a[1], a[2], a[3]); w.y = pk_fp8x4(a[4], a[5], a[6], a[7]);
                    *(GAS u32x2*)((unsigned char*)ACT + (size_t)u.pm * BM * FF + (size_t)u.pn * 32768 + (size_t)(wr * 64 + fr + ai * HALF + m * 16) * 128 + (f0 - u.pn * 128)) = w; }
                else { u32x4 w; w.x = cvt_pk_bf16(a[0], a[1]); w.y = cvt_pk_bf16(a[2], a[3]); w.z = cvt_pk_bf16(a[4], a[5]); w.w = cvt_pk_bf16(a[6], a[7]);
                    *(GAS u32x4*)(ACT + (size_t)(row0 + ai * HALF + m * 16) * FF + f0) = w; } }
    }
};
struct EpiMoe2 {
#ifndef REP_EPIMOE2
#define REP_EPIMOE2 1
#endif
    static constexpr int REP = REP_EPIMOE2;
    bf16_t* Y; const float* b2; const int* slot_asg; const float* slot_gate; const LAS int* lcnt;
    __device__ __forceinline__ void opaque() { Y = uni_ptr(Y); b2 = uni_ptr(b2); slot_asg = uni_ptr(slot_asg); slot_gate = uni_ptr(slot_gate); unsigned lc_ = (unsigned)__builtin_amdgcn_readfirstlane((int)(unsigned)(uintptr_t)lcnt);
        asm volatile("" : "+s"(Y), "+s"(b2), "+s"(slot_asg), "+s"(slot_gate), "+s"(lc_)); lcnt = (const LAS int*)(uintptr_t)lc_; }
    static constexpr int NSIDE = 3;
    __device__ __forceinline__ const char* side_src(const Unit& u, int j) const {
        return j == 0 ? (const char*)(b2 + (size_t)u.e * D + (size_t)u.pn * BM) : j == 1 ? (const char*)(slot_asg + (size_t)u.e * CAP + (size_t)u.mt * BM) : (const char*)(slot_gate + (size_t)u.e * CAP + (size_t)u.mt * BM); }
    __device__ __forceinline__ void operator()(const f32x4 (&acc)[2][2][4][2], const Unit& u, int wr, int wc, int fr, int fq, const LAS unsigned char* side) const {
        const int c0 = W2_Q16 ? u.pn * BM + wc * 64 + fq * 16 : u.pn * BM + wc * 32 + fq * 8; const int n_e = __builtin_amdgcn_readfirstlane(lcnt[u.e]);
        f32x4 bv[2][2];
#pragma unroll
        for (int bj = 0; bj < 2; ++bj)
#pragma unroll
            for (int n = 0; n < 2; ++n) bv[bj][n] = *(const LAS f32x4*)(side + (W2_Q16 ? wc * 64 + fq * 16 + bj * 8 + 4 * n : wc * 32 + fq * 8 + bj * HALF + 4 * n) * 4);
        int asg[2][4]; float gtv[2][4];
#pragma unroll
        for (int ai = 0; ai < 2; ++ai)
#pragma unroll
            for (int m = 0; m < 4; ++m) { const int pl = ai * HALF + wr * 64 + m * 16 + fr; asg[ai][m] = *(const LAS int*)(side + 1024 + pl * 4); gtv[ai][m] = *(const LAS float*)(side + 2048 + pl * 4); }
#pragma unroll
        for (int ai = 0; ai < 2; ++ai)
#pragma unroll
            for (int m = 0; m < 4; ++m) { const int pos = u.mt * BM + ai * HALF + wr * 64 + m * 16 + fr;
                if (pos < n_e) {
                    unsigned char* rowp = (unsigned char*)Y + (size_t)asg[ai][m] * D + c0;
                    const float gs = gtv[ai][m] * Y8_SCALE;
                    constexpr float WS2 = FP8_MOE2 ? 1.0f / W8_SCALE : 1.0f;
                    if constexpr (W2_Q16 != 0) { u32x4 w4;
#pragma unroll
                        for (int bj = 0; bj < 2; ++bj) { const f32x4 v0 = (acc[ai][bj][m][0] * WS2 + bv[bj][0]) * gs, v1 = (acc[ai][bj][m][1] * WS2 + bv[bj][1]) * gs;
                            w4[2 * bj] = pk_fp8x4(v0[0], v0[1], v0[2], v0[3]); w4[2 * bj + 1] = pk_fp8x4(v1[0], v1[1], v1[2], v1[3]); }
                        *(GAS u32x4*)rowp = w4; }
                    else {
#pragma unroll
                    for (int bj = 0; bj < 2; ++bj) {
                        const f32x4 v0 = (acc[ai][bj][m][0] * WS2 + bv[bj][0]) * gs, v1 = (acc[ai][bj][m][1] * WS2 + bv[bj][1]) * gs;
                        u32x2 w; w.x = pk_fp8x4(v0[0], v0[1], v0[2], v0[3]); w.y = pk_fp8x4(v1[0], v1[1], v1[2], v1[3]);
                        *(GAS u32x2*)(rowp + bj * HALF) = w; } } } }
    }
};
}

#define XB_TMO      128
#define XB_XCNT(j)  (256  + 64 * (j))
#define XB_XSUB(j)  (1280 + 64 * (j))
#define XB_XGEN(j)  (2304 + 64 * (j))
#define XB_TOP      3328
#define XB_TOPGEN   3392
#define XCD_BAR_WORDS 3456
#define XB_SPIN_CAP (1u << 18)
__device__ __forceinline__ unsigned xb_ld(unsigned* p)              { return __hip_atomic_load(p, __ATOMIC_RELAXED, __HIP_MEMORY_SCOPE_AGENT); }
__device__ __forceinline__ unsigned xb_add(unsigned* p, unsigned v) { return __hip_atomic_fetch_add(p, v, __ATOMIC_RELAXED, __HIP_MEMORY_SCOPE_AGENT); }
__device__ __forceinline__ unsigned xb_xcc_id() { return (unsigned)__builtin_amdgcn_s_getreg((3 << 11) | 20) & 0xFu; }
#define XB_SPIN(cond, bar) do { unsigned _sp = 0; while (cond) { __builtin_amdgcn_s_sleep(1); \
    if ((++_sp & 255u) == 0u) { if (xb_ld(&(bar)[XB_TMO])) break; if (_sp > XB_SPIN_CAP) { atomicAdd(&(bar)[XB_TMO], 1u); break; } } } } while (0)
struct XcdBarrier { unsigned* bar; unsigned x; volatile LAS unsigned* st; };
__device__ __forceinline__ XcdBarrier xcd_barrier_post(unsigned* bar, volatile LAS unsigned* st) {
    XcdBarrier b; b.bar = bar; b.x = xb_xcc_id(); b.st = st;
    if (threadIdx.x == 0) (void)xb_add(&bar[XB_XCNT(b.x)], 1u);
    return b;
}
__device__ __forceinline__ void xcd_barrier_complete(unsigned* bar, unsigned x, unsigned& nloc, unsigned& nx) {
    const unsigned G = gridDim.x * gridDim.y * gridDim.z;
    unsigned sum, cnt, mine, sp = 0u;
    for (;;) {
        sum = 0u; cnt = 0u; mine = 0u;
#pragma unroll
        for (unsigned j = 0; j < 16; ++j) { const unsigned c = xb_ld(&bar[XB_XCNT(j)]); sum += c; cnt += (c > 0u) ? 1u : 0u; mine = (j == x) ? c : mine; }
        if (sum == G) break;
        __builtin_amdgcn_s_sleep(1);
        if ((++sp & 255u) == 0u) { if (xb_ld(&bar[XB_TMO])) break; if (sp > XB_SPIN_CAP) { atomicAdd(&bar[XB_TMO], 1u); break; } }
    }
    nloc = mine > 0u ? mine : 1u; nx = cnt > 0u ? cnt : 1u;
}
__device__ __forceinline__ void xcd_barrier(const XcdBarrier& b) {
    asm volatile("s_waitcnt vmcnt(0)" ::: "memory");
    __syncthreads();
    if (threadIdx.x == 0) {
        unsigned* bar = b.bar;
        __builtin_amdgcn_s_waitcnt(0);
        unsigned nloc = b.st[0], nx = b.st[1];
        if (nloc == 0u) { xcd_barrier_complete(bar, b.x, nloc, nx); b.st[0] = nloc; b.st[1] = nx; }
        const unsigned old = xb_add(&bar[XB_XSUB(b.x)], 1u);
        const unsigned gen = old / nloc;
        if (old + 1u == (gen + 1u) * nloc) {
            __builtin_amdgcn_fence(__ATOMIC_RELEASE, "agent");
            asm volatile("s_waitcnt vmcnt(0)" ::: "memory");
            const unsigned og = xb_add(&bar[XB_TOP], 1u);
            const unsigned tg = og / nx;
            if (og + 1u == (tg + 1u) * nx) xb_add(&bar[XB_TOPGEN], 1u);
            else XB_SPIN(xb_ld(&bar[XB_TOPGEN]) == tg, bar);
            __builtin_amdgcn_fence(__ATOMIC_ACQUIRE, "agent");
            xb_add(&bar[XB_XGEN(b.x)], 1u);
            asm volatile("s_waitcnt vmcnt(0)" ::: "memory");
        } else {
            XB_SPIN(xb_ld(&bar[XB_XGEN(b.x)]) == gen, bar);
            __builtin_amdgcn_fence(__ATOMIC_ACQUIRE, "agent");
            asm volatile("s_waitcnt vmcnt(0)" ::: "memory");
        }
    }
    __syncthreads();
}

struct Args { const float* in[25]; float* out; unsigned char* ws; int ph_lo, ph_hi; };
struct Frame {
    LAS unsigned char* lds; volatile LAS unsigned* MISC; unsigned* ctl;
    int tid, lane, wave, vcu, G, bx;
    const __attribute__((address_space(4))) Args* ka; float* out; unsigned char* ws;
};
enum { I_X = 0, I_C, I_CTX, I_CCTX, I_N1G, I_N2G, I_ADAW, I_ADAB, I_WIN, I_SINK, I_SGUWS, I_SGUB, I_SGULNG, I_SGULNB, I_POOLW, I_POOLS, I_CONVW, I_WOUT, I_RW, I_RB, I_W1, I_B1, I_W2, I_B2, I_FG };

__device__ __forceinline__ void conv_item(const float* W, int ldw, int colbase, int cstride, bf16_t* Bt, int K, int prow0, int k0, bool perm, LAS float* scr, int lane) {
    { float t_[32]; const float* wp_ = W + (size_t)(k0 + (lane >> 5)) * ldw + colbase + (lane & 31) * cstride;
#pragma unroll
      for (int i = 0; i < 32; ++i) t_[i] = wp_[(size_t)(2 * i) * ldw];
#pragma unroll
      for (int i = 0; i < 32; ++i) scr[(2 * i + (lane >> 5)) * 33 + (lane & 31)] = t_[i]; }
    LDS_WAIT(); asm volatile("" ::: "memory");
    const int c = lane & 7;
#pragma unroll
    for (int j = 0; j < 4; ++j) { const int n = (lane >> 3) + 8 * j; const int o = perm ? pg8::perm32(n) : n; const LAS float* s = scr + (8 * c) * 33 + o;
        u32x4 w; w.x = cvt_pk_bf16(s[0 * 33], s[1 * 33]); w.y = cvt_pk_bf16(s[2 * 33], s[3 * 33]); w.z = cvt_pk_bf16(s[4 * 33], s[5 * 33]); w.w = cvt_pk_bf16(s[6 * 33], s[7 * 33]);
        *(u32x4*)(Bt + (size_t)(prow0 + n) * K + k0 + 8 * c) = w; }
    LDS_WAIT(); asm volatile("" ::: "memory");
}
__device__ __forceinline__ void conv_item8(const float* W, int ldw, int colbase, int cstride, unsigned char* Bt, int K, int prow0, int k0, bool perm, LAS float* scr, int lane) {
    { float t_[32]; const float* wp_ = W + (size_t)(k0 + (lane >> 5)) * ldw + colbase + (lane & 31) * cstride;
#pragma unroll
      for (int i = 0; i < 32; ++i) t_[i] = wp_[(size_t)(2 * i) * ldw];
#pragma unroll
      for (int i = 0; i < 32; ++i) scr[(2 * i + (lane >> 5)) * 33 + (lane & 31)] = t_[i]; }
    LDS_WAIT(); asm volatile("" ::: "memory");
    const int c = lane & 7;
#pragma unroll
    for (int j = 0; j < 4; ++j) { const int n = (lane >> 3) + 8 * j; const int o = perm ? pg8::perm32(n) : n; const LAS float* s = scr + (8 * c) * 33 + o;
        u32x2 w; w.x = pk_fp8x4(s[0 * 33] * W8_SCALE, s[1 * 33] * W8_SCALE, s[2 * 33] * W8_SCALE, s[3 * 33] * W8_SCALE); w.y = pk_fp8x4(s[4 * 33] * W8_SCALE, s[5 * 33] * W8_SCALE, s[6 * 33] * W8_SCALE, s[7 * 33] * W8_SCALE);
        { const int p_ = prow0 + n, k_ = k0 + 8 * c; *(u32x2*)(Bt + (size_t)(p_ >> 8) * 256 * K + (size_t)(k_ >> 7) * 32768 + (p_ & 255) * 128 + (k_ & 127)) = w; } }
    LDS_WAIT(); asm volatile("" ::: "memory");
}
__device__ __forceinline__ void conv_item8_pair(const float* W, int ldw, int colbase, unsigned char* Bt, int K, int prow0, int k0, LAS float* scr, int lane) {
    { f32x2 t_[32]; const float* wp_ = W + (size_t)(k0 + (lane >> 5)) * ldw + colbase + (lane & 31) * 2;
#pragma unroll
      for (int i = 0; i < 32; ++i) t_[i] = *(const f32x2*)(wp_ + (size_t)(2 * i) * ldw);
#pragma unroll
      for (int i = 0; i < 32; ++i) { scr[(2 * i + (lane >> 5)) * 33 + (lane & 31)] = t_[i].x; scr[64 * 33 + (2 * i + (lane >> 5)) * 33 + (lane & 31)] = t_[i].y; } }
    LDS_WAIT(); asm volatile("" ::: "memory");
    const int c = lane & 7;
#pragma unroll
    for (int bj = 0; bj < 2; ++bj)
#pragma unroll
        for (int j = 0; j < 4; ++j) { const int n = (lane >> 3) + 8 * j; const int o = pg8::perm32(n); const LAS float* s = scr + bj * 64 * 33 + (8 * c) * 33 + o;
            u32x2 w; w.x = pk_fp8x4(s[0 * 33] * W8_SCALE, s[1 * 33] * W8_SCALE, s[2 * 33] * W8_SCALE, s[3 * 33] * W8_SCALE); w.y = pk_fp8x4(s[4 * 33] * W8_SCALE, s[5 * 33] * W8_SCALE, s[6 * 33] * W8_SCALE, s[7 * 33] * W8_SCALE);
            { const int p_ = prow0 + bj * 128 + n, k_ = k0 + 8 * c; *(u32x2*)(Bt + (size_t)(p_ >> 8) * 256 * K + (size_t)(k_ >> 7) * 32768 + (p_ & 255) * 128 + (k_ & 127)) = w; } }
    LDS_WAIT(); asm volatile("" ::: "memory");
}
__device__ __forceinline__ void conv_item8_q(const float* W, int ldw, int colbase, unsigned char* Bt, int K, int prow0, int k0, LAS float* scr, int lane) {
    { f32x2 t_[32]; const float* wp_ = W + (size_t)(k0 + (lane >> 5)) * ldw + colbase + (lane & 31) * 2;
#pragma unroll
      for (int i = 0; i < 32; ++i) t_[i] = *(const f32x2*)(wp_ + (size_t)(2 * i) * ldw);
      const int c = (lane & 31) * 2; const int rho = 16 * ((c >> 2) & 1) + 4 * (c >> 4) + (c & 3), bjc = (c >> 3) & 1;
#pragma unroll
      for (int i = 0; i < 32; ++i) { scr[bjc * 64 * 33 + (2 * i + (lane >> 5)) * 33 + rho] = t_[i].x; scr[bjc * 64 * 33 + (2 * i + (lane >> 5)) * 33 + rho + 1] = t_[i].y; } }
    LDS_WAIT(); asm volatile("" ::: "memory");
    const int c8 = lane & 7;
#pragma unroll
    for (int bj = 0; bj < 2; ++bj)
#pragma unroll
        for (int j = 0; j < 4; ++j) { const int n = (lane >> 3) + 8 * j; const LAS float* s = scr + bj * 64 * 33 + (8 * c8) * 33 + n;
            u32x2 w; w.x = pk_fp8x4(s[0 * 33] * W8_SCALE, s[1 * 33] * W8_SCALE, s[2 * 33] * W8_SCALE, s[3 * 33] * W8_SCALE); w.y = pk_fp8x4(s[4 * 33] * W8_SCALE, s[5 * 33] * W8_SCALE, s[6 * 33] * W8_SCALE, s[7 * 33] * W8_SCALE);
            { const int p_ = prow0 + bj * 128 + n, k_ = k0 + 8 * c8; *(u32x2*)(Bt + (size_t)(p_ >> 8) * 256 * K + (size_t)(k_ >> 7) * 32768 + (p_ & 255) * 128 + (k_ & 127)) = w; } }
    LDS_WAIT(); asm volatile("" ::: "memory");
}
__device__ __forceinline__ void p0_prologue(Frame& F) {
    LAS float* scr = (LAS float*)(F.lds + F.wave * 17408);
    const int gw = F.vcu * 8 + F.wave, NGW = F.G * 8;
    constexpr int IT_WIN = (INC / 32) * (D / 64);
    constexpr int IT_WOUT = (D / 32) * (MIXW / 64);
    constexpr int IT_W1 = FP8_MOE1 ? (FF / 32) * (D / 64) : (FF2 / 32) * (D / 64);
    constexpr int IT_W2 = (D / 32) * (FF / 64);
    constexpr int N_WIN = DEPTH * IT_WIN, N_WOUT = DEPTH * IT_WOUT, N_W1 = DEPTH * NE * IT_W1, N_W2 = DEPTH * NE * IT_W2;
    constexpr int NITEMS = N_WIN + N_WOUT;
    (void)N_W1; (void)N_W2;
    for (int it = gw; it < NITEMS; it += NGW) {
        int r = it;
        if (r < N_WIN) { const int l = r / IT_WIN; r -= l * IT_WIN; const int g = r / (D / 64), kb = r % (D / 64); const int pn = g >> 3, gi = g & 7, bj = gi >> 2, wc = gi & 3;
            conv_item(F.ka->in[I_WIN] + (size_t)l * D * INC, INC, pn * 256 + wc * 64 + bj * 32, 1, (bf16_t*)(F.ws + WS_WIN) + (size_t)l * INC * D, D, g * 32, kb * 64, true, scr, F.lane); continue; }
        r -= N_WIN;
        if (r < N_WOUT) { const int l = r / IT_WOUT; r -= l * IT_WOUT; const int g = r / (MIXW / 64), kb = r % (MIXW / 64);
            if (FP8_WOUT) conv_item8(F.ka->in[I_WOUT] + (size_t)l * MIXW * D, D, g * 32, 1, F.ws + WS_WOUT + (size_t)l * D * MIXW, MIXW, g * 32, kb * 64, true, scr, F.lane);
            else conv_item(F.ka->in[I_WOUT] + (size_t)l * MIXW * D, D, g * 32, 1, (bf16_t*)(F.ws + WS_WOUT) + (size_t)l * D * MIXW, MIXW, g * 32, kb * 64, true, scr, F.lane);
            continue; }
    }
    __syncthreads();
    {
        LAS float* part = (LAS float*)F.lds;
        float* mod = (float*)(F.ws + WS_MOD);
        for (int task = F.vcu; task < DEPTH * 96; task += F.G) {
            const int l = task / 96, n0 = (task % 96) * 64;
            const float* aw = F.ka->in[I_ADAW] + (size_t)l * D * 6144 + n0 + F.lane;
            float a0 = 0.f, a1 = 0.f, a2 = 0.f;
            float sl[3][2];
#pragma unroll
            for (int hh = 0; hh < 2; ++hh) { const int k = F.wave * 128 + hh * 64 + F.lane; const float c0 = F.ka->in[I_C][k], c1 = F.ka->in[I_C][D + k], c2 = F.ka->in[I_CCTX][k];
                sl[0][hh] = c0 / (1.f + __expf(-c0)); sl[1][hh] = c1 / (1.f + __expf(-c1)); sl[2][hh] = c2 / (1.f + __expf(-c2)); }
#pragma unroll
            for (int hh = 0; hh < 2; ++hh)
                for (int kb = 0; kb < 64; kb += 32) { float w[32];
#pragma unroll
                    for (int u = 0; u < 32; ++u) w[u] = aw[(size_t)(F.wave * 128 + hh * 64 + kb + u) * 6144];
#pragma unroll
                    for (int u = 0; u < 32; ++u) { const int kk = kb + u;
                        a0 += w[u] * __builtin_bit_cast(float, __builtin_amdgcn_readlane(__builtin_bit_cast(int, sl[0][hh]), kk));
                        a1 += w[u] * __builtin_bit_cast(float, __builtin_amdgcn_readlane(__builtin_bit_cast(int, sl[1][hh]), kk));
                        a2 += w[u] * __builtin_bit_cast(float, __builtin_amdgcn_readlane(__builtin_bit_cast(int, sl[2][hh]), kk)); } }
            part[(F.wave * 3 + 0) * 64 + F.lane] = a0; part[(F.wave * 3 + 1) * 64 + F.lane] = a1; part[(F.wave * 3 + 2) * 64 + F.lane] = a2;
            __syncthreads();
            if (F.tid < 192) { const int j = F.tid >> 6, n = F.tid & 63; float s = 0.f;
#pragma unroll
                for (int w = 0; w < 8; ++w) s += part[(w * 3 + j) * 64 + n];
                mod[(size_t)(l * 3 + j) * 6144 + n0 + n] = s + F.ka->in[I_ADAB][l * 6144 + n0 + n]; }
            __syncthreads();
        }
    }
    {
        bf16_t* sw = (bf16_t*)(F.ws + WS_SGUW); const float* src = F.ka->in[I_SGUWS];
        for (int i = F.vcu * 512 + F.tid; i < DEPTH * 4 * 128 * 128 / 2; i += F.G * 512) ((unsigned*)sw)[i] = cvt_pk_bf16(src[2 * i], src[2 * i + 1]);
        bf16_t* pt = (bf16_t*)(F.ws + WS_POOLWT); const float* ps = F.ka->in[I_POOLW];
        for (int i = F.vcu * 512 + F.tid; i < DEPTH * 4 * 64 * 64; i += F.G * 512) { const int lg = i >> 12, d = (i >> 6) & 63, c = i & 63; pt[i] = (bf16_t)(cvt_pk_bf16(ps[(size_t)lg * 4096 + c * 64 + d], 0.f) & 0xffffu); }
    }
    {
        float* cosT = (float*)(F.ws + WS_ROPE); float* sinT = cosT + 320 * 16;
        for (int i = F.tid * F.G + F.vcu; i < 320 * 16; i += F.G * 512) { const int p = i >> 4, d = i & 15; const int pos = p < 256 ? p : p - 256;
            const float inv = (float)exp2(-(double)d * (13.287712379549449 / 16.0));
            const float ang = (float)pos * inv;
            cosT[i] = cosf(ang); sinT[i] = sinf(ang); }
    }
}

template <bool EARLY> __device__ __forceinline__ void p_convert_w1_t(Frame& F, int l) {
    if (!EARLY) __syncthreads();
    LAS float* scr = (LAS float*)(F.lds + F.wave * 17408);
    const int gw = F.vcu * 8 + F.wave, NGW = F.G * 8;
    constexpr int IT_W1 = FP8_MOE1 ? (FF / 32) * (D / 64) : (FF2 / 32) * (D / 64);
    const bool even = (NE * IT_W1) % NGW == 0;
    constexpr int EROWS = 2;
    if (EARLY && (!even || F.wave < 4)) return;
    const int nmain = even ? NE * IT_W1 - EROWS * NGW : NE * IT_W1;
    const int nloop = EARLY ? 2 * EROWS : (nmain - gw + NGW - 1) / NGW;
    for (int q = 0; q < nloop; ++q) {
        const int it = EARLY ? nmain + (q >> 1) * NGW + F.vcu * 8 + 2 * (F.wave - 4) + (q & 1) : gw + q * NGW;
        int r = it; const int le = l * NE + r / IT_W1; r -= (r / IT_W1) * IT_W1; const int g = r / (D / 64), kb = r % (D / 64); const int pn = g >> 3, gi = g & 7, bj = gi >> 2, wc = gi & 3;
        if (FP8_MOE1) { const int pn8 = g >> 2, wc8 = g & 3;
            conv_item8_pair(F.ka->in[I_W1] + (size_t)le * D * FF2, FF2, 2 * (pn8 * 128 + wc8 * 32), F.ws + WS_W1 + (size_t)le * FF2 * D, D, pn8 * 256 + wc8 * 32, kb * 64, scr, F.lane); }
        else conv_item(F.ka->in[I_W1] + (size_t)le * D * FF2, FF2, 2 * (pn * 128 + wc * 32) + bj, 2, (bf16_t*)(F.ws + WS_W1) + (size_t)le * FF2 * D, D, g * 32, kb * 64, true, scr, F.lane);
    }
    if (!EARLY) __syncthreads();
}
__device__ __forceinline__ void p_convert_w1(Frame& F, int l) { p_convert_w1_t<false>(F, l); }
__device__ __forceinline__ void p_convert_w2(Frame& F, int l) {
    __syncthreads();
    LAS float* scr = (LAS float*)(F.lds + F.wave * 17408);
    const int gw = F.vcu * 8 + F.wave, NGW = F.G * 8;
    constexpr int IT_W2 = (FP8_MOE2 && W2_Q16) ? (D / 64) * (FF / 64) : (D / 32) * (FF / 64);
    for (int it = gw; it < NE * IT_W2; it += NGW) {
        int r = it; const int le = l * NE + r / IT_W2; r -= (r / IT_W2) * IT_W2; const int g = r / (FF / 64), kb = r % (FF / 64);
        if (FP8_MOE2 && W2_Q16) { const int pn = g >> 2, wc = g & 3;
            conv_item8_q(F.ka->in[I_W2] + (size_t)le * FF * D, D, pn * 256 + wc * 64, F.ws + WS_W2 + (size_t)le * D * FF, FF, pn * 256 + wc * 32, kb * 64, scr, F.lane); }
        else if (FP8_MOE2) conv_item8(F.ka->in[I_W2] + (size_t)le * FF * D, D, g * 32, 1, F.ws + WS_W2 + (size_t)le * D * FF, FF, g * 32, kb * 64, true, scr, F.lane);
        else conv_item(F.ka->in[I_W2] + (size_t)le * FF * D, D, g * 32, 1, (bf16_t*)(F.ws + WS_W2) + (size_t)le * D * FF, FF, g * 32, kb * 64, true, scr, F.lane);
    }
    __syncthreads();
}

__device__ __forceinline__ const unsigned char* xrow_b(const Frame& F, int layer, int r) {
    if (layer == 0) return (const unsigned char*)(r < TL ? F.ka->in[I_X] + (size_t)r * D : F.ka->in[I_CTX] + (size_t)(r - TL) * D);
    return F.ws + WS_XL + (size_t)r * D * (XL_BF16 ? 2 : 4);
}
template <bool BF> __device__ __forceinline__ f32x4 ldx4(const unsigned char* rowb, int c) {
    if constexpr (BF) { const u32x2 w = *(const u32x2*)(rowb + (size_t)c * 2); return (f32x4){bflo(w.x), bfhi(w.x), bflo(w.y), bfhi(w.y)}; }
    else return *(const f32x4*)(rowb + (size_t)c * 4);
}
__device__ __forceinline__ const float* xrow_in(const Frame& F, int layer, int r) {
    if (layer == 0) return r < TL ? F.ka->in[I_X] + (size_t)r * D : F.ka->in[I_CTX] + (size_t)(r - TL) * D;
    return (const float*)(F.ws + WS_XL) + (size_t)r * D;
}
__device__ __forceinline__ int mod_index(int r) { return r < TL ? (r >> 14) : 2; }

__device__ __forceinline__ void norm_mod_store(const f32x4 (&v)[4], const float* g, const float* shift, const float* scale, bf16_t* hrow, int lane) {
    float ss = 0.f;
#pragma unroll
    for (int j = 0; j < 4; ++j) ss += (v[j].x * v[j].x + v[j].y * v[j].y) + (v[j].z * v[j].z + v[j].w * v[j].w);
    const float rstd = 1.0f / sqrtf(wave_sum(ss) * (1.f / D) + EPS);
#pragma unroll
    for (int j = 0; j < 4; ++j) { const int c = 4 * lane + 256 * j;
        const f32x4 gg = *(const f32x4*)(g + c), sh = *(const f32x4*)(shift + c), sc = *(const f32x4*)(scale + c);
        const f32x4 y = (v[j] * rstd * gg) * (sc + 1.0f) + sh;
        u32x2 w; w.x = cvt_pk_bf16(y.x, y.y); w.y = cvt_pk_bf16(y.z, y.w);
        *(u32x2*)(hrow + c) = w; }
}
__device__ __forceinline__ void norm_mod_store_pre(const f32x4 (&v)[4], const f32x4 (&gg)[4], const f32x4 (&sh)[4], const f32x4 (&sc)[4], bf16_t* hrow, int lane) {
    float ss = 0.f;
#pragma unroll
    for (int j = 0; j < 4; ++j) ss += (v[j].x * v[j].x + v[j].y * v[j].y) + (v[j].z * v[j].z + v[j].w * v[j].w);
    const float rstd = 1.0f / sqrtf(wave_sum(ss) * (1.f / D) + EPS);
#pragma unroll
    for (int j = 0; j < 4; ++j) { const int c = 4 * lane + 256 * j;
        const f32x4 y = (v[j] * rstd * gg[j]) * (sc[j] + 1.0f) + sh[j];
        u32x2 w; w.x = cvt_pk_bf16(y.x, y.y); w.y = cvt_pk_bf16(y.z, y.w);
        *(u32x2*)(hrow + c) = w; }
}
__device__ __forceinline__ void p_norm1_first(Frame& F) {
    const int gw = F.vcu * 8 + F.wave, NGW = F.G * 8;
    const float* mod = (const float*)(F.ws + WS_MOD);
    bf16_t* H = (bf16_t*)(F.ws + WS_H);
    f32x4 gg[4], sh[4], sc[4]; int cur_mi = -1;
#pragma unroll
    for (int j = 0; j < 4; ++j) gg[j] = *(const f32x4*)(F.ka->in[I_N1G] + 4 * F.lane + 256 * j);
    for (int r = gw; r < MT; r += NGW) {
        const float* x = xrow_in(F, 0, r); const int mi = mod_index(r);
        f32x4 v[4];
#pragma unroll
        for (int j = 0; j < 4; ++j) v[j] = *(const f32x4*)(x + 4 * F.lane + 256 * j);
        if (mi != cur_mi) { cur_mi = mi;
#pragma unroll
            for (int j = 0; j < 4; ++j) { const int c = 4 * F.lane + 256 * j; sh[j] = *(const f32x4*)(mod + (size_t)mi * 6144 + c); sc[j] = *(const f32x4*)(mod + (size_t)mi * 6144 + D + c); } }
        norm_mod_store_pre(v, gg, sh, sc, H + (size_t)r * D, F.lane);
    }
}

typedef float f32x16 __attribute__((ext_vector_type(16)));
#define MFMA32(a, b, c) __builtin_amdgcn_mfma_f32_32x32x16_bf16(a, b, c, 0, 0, 0)
__device__ __forceinline__ int crow(int g, int hi) { return (g & 3) + 8 * (g >> 2) + 4 * hi; }

__device__ __forceinline__ void attn_task(Frame& F, int layer, int g32, int hq) {
    const int lane = F.lane, r32 = lane & 31, hi = lane >> 5, kvh = hq >> 2;
    const bf16_t* P = (const bf16_t*)(F.ws + WS_P); bf16_t* MIX = (bf16_t*)(F.ws + WS_MIX);
    const bf16_t* KFh = (const bf16_t*)(F.ws + WS_KF) + (size_t)kvh * NT32 * 2048 + lane * 8;
    const bf16_t* VFh = (const bf16_t*)(F.ws + WS_VF) + (size_t)kvh * NT32 * 2048 + lane * 8;
    const int qrow = 32 * g32 + r32;
    bf16x8 qf[4];
#pragma unroll
    for (int d0 = 0; d0 < 4; ++d0) qf[d0] = *(const bf16x8*)(P + (size_t)qrow * INC + PC_Q + hq * 64 + 16 * d0 + 8 * hi);
    int tb0, tb1, tc0;
    if (g32 < TL / 32) { const int b = g32 >> 9, s0 = b * 512; tb0 = g32 - 4 < s0 ? s0 : g32 - 4; tb1 = g32 + 5 > s0 + 512 ? s0 + 512 : g32 + 5; tc0 = TL / 32 + b * 8; }
    else { const int b = (g32 - TL / 32) >> 3; tb0 = 0; tb1 = 0; tc0 = TL / 32 + b * 8; }
    const int nb = tb1 - tb0, nt = nb + 8;
    float m = F.ka->in[I_SINK][layer * 8 + hq] * LOG2E, lsum = hi == 0 ? 1.0f : 0.0f;
    f32x16 o0, o1;
#pragma unroll
    for (int g = 0; g < 16; ++g) { o0[g] = 0.f; o1[g] = 0.f; }
    bf16x8 k0[4], v0[4], k1[4], v1[4], k2[4], v2[4];
#define AT_TILE(i) ((i) < nb ? tb0 + (i) : tc0 + ((i) - nb))
#define AT_LOAD(KF, VF, i) do { const size_t to_ = (size_t)AT_TILE(i) * 2048; _Pragma("unroll") for (int j = 0; j < 4; ++j) { KF[j] = *(const bf16x8*)(KFh + to_ + j * 512); VF[j] = *(const bf16x8*)(VFh + to_ + j * 512); } } while (0)
#define AT_COMPUTE(KF, VF, i) do { const int tt = AT_TILE(i); \
        f32x16 sc; _Pragma("unroll") for (int g = 0; g < 16; ++g) sc[g] = 0.f; \
        _Pragma("unroll") for (int d0 = 0; d0 < 4; ++d0) sc = MFMA32(KF[d0], qf[d0], sc); \
        if ((i) < nb) { \
            if (tt == g32 - 4) { _Pragma("unroll") for (int g = 0; g < 16; ++g) sc[g] = (crow(g, hi) >= r32) ? sc[g] : -INFINITY; } \
            if (tt == g32 + 4) { _Pragma("unroll") for (int g = 0; g < 16; ++g) sc[g] = (crow(g, hi) <= r32) ? sc[g] : -INFINITY; } } \
        float tm = sc[0]; _Pragma("unroll") for (int g = 1; g < 16; ++g) tm = __builtin_fmaxf(tm, sc[g]); \
        tm = __builtin_fmaxf(tm, __shfl_xor(tm, 32)); \
        const float mn = __builtin_fmaxf(m, tm); \
        if (__any(mn > m)) { const float al = __builtin_amdgcn_exp2f(m - mn); lsum *= al; _Pragma("unroll") for (int g = 0; g < 16; ++g) { o0[g] *= al; o1[g] *= al; } } \
        m = mn; float ps = 0.f; \
        _Pragma("unroll") for (int g = 0; g < 16; ++g) { sc[g] = __builtin_amdgcn_exp2f(sc[g] - m); ps += sc[g]; } \
        lsum += ps; \
        u32x4 p0, p1; \
        p0.x = cvt_pk_bf16(sc[0], sc[1]); p0.y = cvt_pk_bf16(sc[2], sc[3]); p0.z = cvt_pk_bf16(sc[4], sc[5]); p0.w = cvt_pk_bf16(sc[6], sc[7]); \
        p1.x = cvt_pk_bf16(sc[8], sc[9]); p1.y = cvt_pk_bf16(sc[10], sc[11]); p1.z = cvt_pk_bf16(sc[12], sc[13]); p1.w = cvt_pk_bf16(sc[14], sc[15]); \
        o0 = MFMA32(VF[0], __builtin_bit_cast(bf16x8, p0), o0); o0 = MFMA32(VF[1], __builtin_bit_cast(bf16x8, p1), o0); \
        o1 = MFMA32(VF[2], __builtin_bit_cast(bf16x8, p0), o1); o1 = MFMA32(VF[3], __builtin_bit_cast(bf16x8, p1), o1); } while (0)
    AT_LOAD(k0, v0, 0); AT_LOAD(k1, v1, 1);
    for (int i = 0; i < nt; i += 3) {
        if (i + 2 < nt) AT_LOAD(k2, v2, i + 2);
        AT_COMPUTE(k0, v0, i);
        if (i + 1 < nt) { if (i + 3 < nt) AT_LOAD(k0, v0, i + 3); AT_COMPUTE(k1, v1, i + 1); }
        if (i + 2 < nt) { if (i + 4 < nt) AT_LOAD(k1, v1, i + 4); AT_COMPUTE(k2, v2, i + 2); }
    }
#undef AT_TILE
#undef AT_LOAD
#undef AT_COMPUTE
    const float rl = 1.0f / (lsum + __shfl_xor(lsum, 32));
    if (FP8_WOUT) { unsigned char* orow8 = (unsigned char*)MIX + (size_t)qrow * MIXW + hq * 64 + 4 * hi;
#pragma unroll
        for (int i4 = 0; i4 < 4; ++i4) { *(unsigned*)(orow8 + 8 * i4) = pk_mix8(o0[4 * i4] * rl, o0[4 * i4 + 1] * rl, o0[4 * i4 + 2] * rl, o0[4 * i4 + 3] * rl);
            *(unsigned*)(orow8 + 32 + 8 * i4) = pk_mix8(o1[4 * i4] * rl, o1[4 * i4 + 1] * rl, o1[4 * i4 + 2] * rl, o1[4 * i4 + 3] * rl); }
        return; }
    bf16_t* orow = MIX + (size_t)qrow * MIXW + hq * 64 + 4 * hi;
#pragma unroll
    for (int i4 = 0; i4 < 4; ++i4) {
        u32x2 w; w.x = cvt_pk_bf16(o0[4 * i4] * rl, o0[4 * i4 + 1] * rl); w.y = cvt_pk_bf16(o0[4 * i4 + 2] * rl, o0[4 * i4 + 3] * rl); *(u32x2*)(orow + 8 * i4) = w;
        u32x2 x; x.x = cvt_pk_bf16(o1[4 * i4] * rl, o1[4 * i4 + 1] * rl); x.y = cvt_pk_bf16(o1[4 * i4 + 2] * rl, o1[4 * i4 + 3] * rl); *(u32x2*)(orow + 32 + 8 * i4) = x; }
}

struct AttnHead { bf16x8 qf[4]; float m, lsum; f32x16 o0, o1; };
__device__ __forceinline__ void attn_tile(AttnHead& h, const bf16x8 (&KF)[4], const bf16x8 (&VF)[4], int maskmode, int r32, int hi) {
    f32x16 sc;
#pragma unroll
    for (int g = 0; g < 16; ++g) sc[g] = 0.f;
#pragma unroll
    for (int d0 = 0; d0 < 4; ++d0) sc = MFMA32(KF[d0], h.qf[d0], sc);
    if (maskmode != 0) {
        asm volatile("" ::: "memory");
        if (maskmode == 1) {
#pragma unroll
            for (int g = 0; g < 16; ++g) sc[g] = (crow(g, hi) >= r32) ? sc[g] : -INFINITY; }
        else {
#pragma unroll
            for (int g = 0; g < 16; ++g) sc[g] = (crow(g, hi) <= r32) ? sc[g] : -INFINITY; }
    }
    float tm = sc[0];
#pragma unroll
    for (int g = 1; g < 16; ++g) tm = __builtin_fmaxf(tm, sc[g]);
    tm = __builtin_fmaxf(tm, __shfl_xor(tm, 32));
    const float mn = __builtin_fmaxf(h.m, tm);
    if (__any(mn > h.m)) { const float al = __builtin_amdgcn_exp2f(h.m - mn); h.lsum *= al;
#pragma unroll
        for (int g = 0; g < 16; ++g) { h.o0[g] *= al; h.o1[g] *= al; } }
    h.m = mn; float ps = 0.f;
#pragma unroll
    for (int g = 0; g < 16; ++g) { sc[g] = __builtin_amdgcn_exp2f(sc[g] - mn); ps += sc[g]; }
    h.lsum += ps;
    u32x4 p0, p1;
    p0.x = cvt_pk_bf16(sc[0], sc[1]); p0.y = cvt_pk_bf16(sc[2], sc[3]); p0.z = cvt_pk_bf16(sc[4], sc[5]); p0.w = cvt_pk_bf16(sc[6], sc[7]);
    p1.x = cvt_pk_bf16(sc[8], sc[9]); p1.y = cvt_pk_bf16(sc[10], sc[11]); p1.z = cvt_pk_bf16(sc[12], sc[13]); p1.w = cvt_pk_bf16(sc[14], sc[15]);
    h.o0 = MFMA32(VF[0], __builtin_bit_cast(bf16x8, p0), h.o0); h.o0 = MFMA32(VF[1], __builtin_bit_cast(bf16x8, p1), h.o0);
    h.o1 = MFMA32(VF[2], __builtin_bit_cast(bf16x8, p0), h.o1); h.o1 = MFMA32(VF[3], __builtin_bit_cast(bf16x8, p1), h.o1);
}
__device__ __forceinline__ void attn_task2(Frame& F, int layer, int g32, int hp) {
    const int lane = F.lane, r32 = lane & 31, hi = lane >> 5, kvh = hp >> 1;
    const bf16_t* P = (const bf16_t*)(F.ws + WS_P); bf16_t* MIX = (bf16_t*)(F.ws + WS_MIX);
    const bf16_t* KFh = (const bf16_t*)(F.ws + WS_KF) + (size_t)kvh * NT32 * 2048 + lane * 8;
    const bf16_t* VFh = (const bf16_t*)(F.ws + WS_VF) + (size_t)kvh * NT32 * 2048 + lane * 8;
    const int qrow = 32 * g32 + r32;
    AttnHead h[2];
#pragma unroll
    for (int q = 0; q < 2; ++q) { const int hq = 2 * hp + q;
#pragma unroll
        for (int d0 = 0; d0 < 4; ++d0) h[q].qf[d0] = *(const bf16x8*)(P + (size_t)qrow * INC + PC_Q + hq * 64 + 16 * d0 + 8 * hi);
        h[q].m = F.ka->in[I_SINK][layer * 8 + hq] * LOG2E; h[q].lsum = hi == 0 ? 1.0f : 0.0f;
#pragma unroll
        for (int g = 0; g < 16; ++g) { h[q].o0[g] = 0.f; h[q].o1[g] = 0.f; } }
    int tb0, tb1, tc0;
    if (g32 < TL / 32) { const int b = g32 >> 9, s0 = b * 512; tb0 = g32 - 4 < s0 ? s0 : g32 - 4; tb1 = g32 + 5 > s0 + 512 ? s0 + 512 : g32 + 5; tc0 = TL / 32 + b * 8; }
    else { const int b = (g32 - TL / 32) >> 3; tb0 = 0; tb1 = 0; tc0 = TL / 32 + b * 8; }
    const int nb = tb1 - tb0, nt = nb + 8;
    bf16x8 k0[4], v0[4], k1[4], v1[4];
#define AT_TILE(i) ((i) < nb ? tb0 + (i) : tc0 + ((i) - nb))
#define AT_LOAD(KF, VF, i) do { const size_t to_ = (size_t)AT_TILE(i) * 2048; _Pragma("unroll") for (int j = 0; j < 4; ++j) { KF[j] = *(const bf16x8*)(KFh + to_ + j * 512); VF[j] = *(const bf16x8*)(VFh + to_ + j * 512); } } while (0)
#define AT_COMPUTE(KF, VF, i) do { const int tt = AT_TILE(i); const int mk = ((i) < nb) ? (tt == g32 - 4 ? 1 : (tt == g32 + 4 ? 2 : 0)) : 0; \
        attn_tile(h[0], KF, VF, mk, r32, hi); attn_tile(h[1], KF, VF, mk, r32, hi); } while (0)
    AT_LOAD(k0, v0, 0);
    for (int i = 0; i < nt; i += 2) {
        if (i + 1 < nt) AT_LOAD(k1, v1, i + 1);
        AT_COMPUTE(k0, v0, i);
        if (i + 1 < nt) { if (i + 2 < nt) AT_LOAD(k0, v0, i + 2); AT_COMPUTE(k1, v1, i + 1); }
    }
#undef AT_TILE
#undef AT_LOAD
#undef AT_COMPUTE
#pragma unroll
    for (int q = 0; q < 2; ++q) { const int hq = 2 * hp + q;
        const float rl = 1.0f / (h[q].lsum + __shfl_xor(h[q].lsum, 32));
        if (FP8_WOUT) { unsigned char* orow8 = (unsigned char*)MIX + (size_t)qrow * MIXW + hq * 64 + 4 * hi;
#pragma unroll
            for (int i4 = 0; i4 < 4; ++i4) { *(unsigned*)(orow8 + 8 * i4) = pk_mix8(h[q].o0[4 * i4] * rl, h[q].o0[4 * i4 + 1] * rl, h[q].o0[4 * i4 + 2] * rl, h[q].o0[4 * i4 + 3] * rl);
                *(unsigned*)(orow8 + 32 + 8 * i4) = pk_mix8(h[q].o1[4 * i4] * rl, h[q].o1[4 * i4 + 1] * rl, h[q].o1[4 * i4 + 2] * rl, h[q].o1[4 * i4 + 3] * rl); } }
        else { bf16_t* orow = MIX + (size_t)qrow * MIXW + hq * 64 + 4 * hi;
#pragma unroll
        for (int i4 = 0; i4 < 4; ++i4) {
            u32x2 w; w.x = cvt_pk_bf16(h[q].o0[4 * i4] * rl, h[q].o0[4 * i4 + 1] * rl); w.y = cvt_pk_bf16(h[q].o0[4 * i4 + 2] * rl, h[q].o0[4 * i4 + 3] * rl); *(u32x2*)(orow + 8 * i4) = w;
            u32x2 x; x.x = cvt_pk_bf16(h[q].o1[4 * i4] * rl, h[q].o1[4 * i4 + 1] * rl); x.y = cvt_pk_bf16(h[q].o1[4 * i4 + 2] * rl, h[q].o1[4 * i4 + 3] * rl); *(u32x2*)(orow + 32 + 8 * i4) = x; } } }
}

constexpr int VNT_STRIDE = 136;
constexpr int DT_STRIDE = 264;
constexpr int G_XS_OFF = 0, G_D_OFF = 144 * 256 * 2;
__device__ __forceinline__ void gated_chunk(Frame& F, int layer, int chunk) {
    const bf16_t* P = (const bf16_t*)(F.ws + WS_P); bf16_t* MIX = (bf16_t*)(F.ws + WS_MIX);
    const int R0 = chunk * 128; const bool lat = R0 < TL;
    const int seq0 = lat ? (R0 & ~(S - 1)) : TL + ((R0 - TL) & ~(LC - 1)); const int nseq = lat ? S : LC;
    int tid = F.tid; asm volatile("" : "+v"(tid)); const int lane = tid & 63, wave = F.wave, r32 = lane & 31, hi = lane >> 5;
    {
        LAS bf16_t* vnT = (LAS bf16_t*)F.lds;
        const float* lng = F.ka->in[I_SGULNG] + layer * 256; const float* lnb = F.ka->in[I_SGULNB] + layer * 256;
        float gq[4], bq[4];
#pragma unroll
        for (int i = 0; i < 4; ++i) { gq[i] = lng[lane + 64 * i]; bq[i] = lnb[lane + 64 * i]; }
        for (int pass = 0; pass < 2; ++pass) { const int rb = wave * 16 + pass * 8;
            float x[8][4];
#pragma unroll
            for (int rr = 0; rr < 8; ++rr)
#pragma unroll
                for (int i = 0; i < 4; ++i) x[rr][i] = bf2f(P[(size_t)(R0 + rb + rr) * INC + PC_SV + lane + 64 * i]);
            float mu[8], q[8];
#pragma unroll
            for (int rr = 0; rr < 8; ++rr) mu[rr] = (x[rr][0] + x[rr][1]) + (x[rr][2] + x[rr][3]);
#pragma unroll
            for (int o = 1; o < 64; o <<= 1)
#pragma unroll
                for (int rr = 0; rr < 8; ++rr) mu[rr] += __shfl_xor(mu[rr], o);
#pragma unroll
            for (int rr = 0; rr < 8; ++rr) { mu[rr] *= (1.f / 256.f); q[rr] = 0.f;
#pragma unroll
                for (int i = 0; i < 4; ++i) { x[rr][i] -= mu[rr]; q[rr] += x[rr][i] * x[rr][i]; } }
#pragma unroll
            for (int o = 1; o < 64; o <<= 1)
#pragma unroll
                for (int rr = 0; rr < 8; ++rr) q[rr] += __shfl_xor(q[rr], o);
#pragma unroll
            for (int rr = 0; rr < 8; ++rr) { const float rstd = 1.0f / sqrtf(q[rr] * (1.f / 256.f) + EPS);
#pragma unroll
                for (int i = 0; i < 4; ++i) x[rr][i] = x[rr][i] * rstd * gq[i] + bq[i]; }
#pragma unroll
            for (int i = 0; i < 4; ++i) { u32x4 w; w.x = cvt_pk_bf16(x[0][i], x[1][i]); w.y = cvt_pk_bf16(x[2][i], x[3][i]); w.z = cvt_pk_bf16(x[4][i], x[5][i]); w.w = cvt_pk_bf16(x[6][i], x[7][i]);
                *(LAS u32x4*)(vnT + (lane + 64 * i) * VNT_STRIDE + rb) = w; }
        }
        __syncthreads();
        const int h = wave >> 1, dt = wave & 1;
        bf16x8 bfr[8];
#pragma unroll
        for (int sx = 0; sx < 8; ++sx) bfr[sx] = *(const LAS bf16x8*)(vnT + (h * 64 + dt * 32 + r32) * VNT_STRIDE + 16 * sx + 8 * hi);
        const bf16_t* wsb = (const bf16_t*)(F.ws + WS_SGUW) + ((size_t)layer * 4 + h) * 128 * 128;
        const float* bsv = F.ka->in[I_SGUB] + (layer * 4 + h) * 128;
        const int cb = h * 64 + dt * 32 + 4 * hi;
#pragma unroll
        for (int half = 0; half < 2; ++half) {
            bf16x8 af[2][8]; u32x2 uv[2][4]; float bsp[2];
#pragma unroll
            for (int q = 0; q < 2; ++q) { const int p = (half * 2 + q) * 32 + r32;
#pragma unroll
                for (int sx = 0; sx < 8; ++sx) af[q][sx] = *(const bf16x8*)(wsb + (size_t)p * 128 + 16 * sx + 8 * hi);
#pragma unroll
                for (int i4 = 0; i4 < 4; ++i4) uv[q][i4] = *(const u32x2*)(P + (size_t)(R0 + p) * INC + PC_SU + cb + 8 * i4);
                bsp[q] = bsv[p]; }
#pragma unroll
            for (int q = 0; q < 2; ++q) { const int p = (half * 2 + q) * 32 + r32;
                f32x16 acc;
#pragma unroll
                for (int g = 0; g < 16; ++g) acc[g] = 0.f;
#pragma unroll
                for (int sx = 0; sx < 8; ++sx) acc = MFMA32(bfr[sx], af[q][sx], acc);
#pragma unroll
                for (int i4 = 0; i4 < 4; ++i4) { const float z0 = bflo(uv[q][i4].x) * (acc[4 * i4] + bsp[q]), z1 = bfhi(uv[q][i4].x) * (acc[4 * i4 + 1] + bsp[q]), z2 = bflo(uv[q][i4].y) * (acc[4 * i4 + 2] + bsp[q]), z3 = bfhi(uv[q][i4].y) * (acc[4 * i4 + 3] + bsp[q]);
                    if (FP8_WOUT) *(unsigned*)((unsigned char*)MIX + (size_t)(R0 + p) * MIXW + 512 + cb + 8 * i4) = pk_mix8(z0, z1, z2, z3);
                    else { u32x2 w; w.x = cvt_pk_bf16(z0, z1); w.y = cvt_pk_bf16(z2, z3); *(u32x2*)(MIX + (size_t)(R0 + p) * MIXW + 512 + cb + 8 * i4) = w; } } }
        }
        __syncthreads();
    }
    {
        LAS bf16_t* xs = (LAS bf16_t*)(F.lds + G_XS_OFF); LAS bf16_t* dT = (LAS bf16_t*)(F.lds + G_D_OFF);
        { u32x4 w[9];
#pragma unroll
          for (int k = 0; k < 9; ++k) { const int i = tid + 512 * k; const int rr = i >> 5, c8 = (i & 31) * 8; const int gr = R0 - 8 + rr;
              w[k] = (u32x4){0u, 0u, 0u, 0u};
              if (gr >= seq0 && gr < seq0 + nseq) w[k] = *(const u32x4*)(P + (size_t)gr * INC + PC_XP + c8); }
#pragma unroll
          for (int k = 0; k < 9; ++k) { const int i = tid + 512 * k; const int rr = i >> 5, c8 = (i & 31) * 8; *(LAS u32x4*)(xs + rr * 256 + c8) = w[k]; } }
        __syncthreads();
        {
            const int cp = tid & 127, c2 = cp * 2, sg = tid >> 7, hw = 1 << (cp >> 5);
            const int t0 = R0 + sg * 32 - seq0;
            const LAS bf16_t* xc = xs + (sg * 32 + 8) * 256 + c2;
            float s0 = 0.f, s1 = 0.f;
            for (int o = -hw; o < hw; ++o) { const int j = t0 + o; if (j >= 0 && j < nseq) { const unsigned wv = *(const LAS unsigned*)(xc + o * 256); s0 += bflo(wv); s1 += bfhi(wv); } }
            unsigned outv[32];
#pragma unroll
            for (int k = 0; k < 32; ++k) { const int t = t0 + k;
                int lo = t - hw, hi2 = t + hw; if (lo < 0) lo = 0; if (hi2 > nseq) hi2 = nseq;
                const unsigned xv = *(const LAS unsigned*)(xc + k * 256); const float inv = 1.0f / (float)(hi2 - lo);
                outv[k] = cvt_pk_bf16(s0 * inv - bflo(xv), s1 * inv - bfhi(xv));
                const int je = t + hw, jl = t - hw;
                const unsigned we = *(const LAS unsigned*)(xc + (k + hw) * 256), wl = *(const LAS unsigned*)(xc + (k - hw) * 256);
                if (je < nseq) { s0 += bflo(we); s1 += bfhi(we); }
                if (jl >= 0) { s0 -= bflo(wl); s1 -= bfhi(wl); } }
#pragma unroll
            for (int k = 0; k < 32; ++k) *(LAS unsigned*)(dT + (sg * 32 + k) * DT_STRIDE + c2) = outv[k];
        }
        __syncthreads();
        const int g = wave >> 1, ddt = wave & 1;
        const bf16_t* pwt = (const bf16_t*)(F.ws + WS_POOLWT) + ((size_t)layer * 4 + g) * 64 * 64;
        bf16x8 bfr[4];
#pragma unroll
        for (int sx = 0; sx < 4; ++sx) bfr[sx] = *(const bf16x8*)(pwt + (size_t)(ddt * 32 + r32) * 64 + 16 * sx + 8 * hi);
        const int cb = g * 64 + ddt * 32 + 4 * hi;
        f32x4 psc[4];
#pragma unroll
        for (int i4 = 0; i4 < 4; ++i4) psc[i4] = *(const f32x4*)(F.ka->in[I_POOLS] + layer * 256 + cb + 8 * i4);
#pragma unroll
        for (int tt = 0; tt < 4; ++tt) {
            f32x16 acc;
#pragma unroll
            for (int q = 0; q < 16; ++q) acc[q] = 0.f;
#pragma unroll
            for (int sx = 0; sx < 4; ++sx) { const bf16x8 df = *(const LAS bf16x8*)(dT + (tt * 32 + r32) * DT_STRIDE + g * 64 + 16 * sx + 8 * hi); acc = MFMA32(bfr[sx], df, acc); }
#pragma unroll
            for (int i4 = 0; i4 < 4; ++i4) {
                if (FP8_WOUT) *(unsigned*)((unsigned char*)MIX + (size_t)(R0 + tt * 32 + r32) * MIXW + 768 + cb + 8 * i4) = pk_mix8(acc[4 * i4] * psc[i4].x, acc[4 * i4 + 1] * psc[i4].y, acc[4 * i4 + 2] * psc[i4].z, acc[4 * i4 + 3] * psc[i4].w);
                else { u32x2 w; w.x = cvt_pk_bf16(acc[4 * i4] * psc[i4].x, acc[4 * i4 + 1] * psc[i4].y); w.y = cvt_pk_bf16(acc[4 * i4 + 2] * psc[i4].z, acc[4 * i4 + 3] * psc[i4].w);
                *(u32x2*)(MIX + (size_t)(R0 + tt * 32 + r32) * MIXW + 768 + cb + 8 * i4) = w; } }
        }
    }
    __syncthreads();
}
__device__ __forceinline__ void conv_pass(Frame& F, int layer, int nrows) {
    const bf16_t* P = (const bf16_t*)(F.ws + WS_P); bf16_t* MIX = (bf16_t*)(F.ws + WS_MIX);
    const int gw = F.vcu * 8 + F.wave, NGW = F.G * 8, c4 = 4 * F.lane;
    const float* cw = F.ka->in[I_CONVW] + layer * 3 * 256;
    const f32x4 w0 = *(const f32x4*)(cw + c4), w1 = *(const f32x4*)(cw + 256 + c4), w2 = *(const f32x4*)(cw + 512 + c4);
    for (int task = gw; task < nrows / 8; task += NGW) {
        const int r0 = task * 8; const bool lat = r0 < TL;
        const int seq0 = lat ? (r0 & ~(S - 1)) : TL + ((r0 - TL) & ~(LC - 1)); const int nseq = lat ? S : LC;
        u32x2 a[10], b[10], c[8];
#pragma unroll
        for (int i = 0; i < 10; ++i) { const int kr = r0 - 1 + i; a[i] = (u32x2){0u, 0u}; b[i] = (u32x2){0u, 0u};
            if (kr >= seq0 && kr < seq0 + nseq) { a[i] = *(const u32x2*)(P + (size_t)kr * INC + PC_CC + c4); b[i] = *(const u32x2*)(P + (size_t)kr * INC + PC_CX + c4); } }
#pragma unroll
        for (int i = 0; i < 8; ++i) c[i] = *(const u32x2*)(P + (size_t)(r0 + i) * INC + PC_CB + c4);
        f32x4 y[10];
#pragma unroll
        for (int i = 0; i < 10; ++i) y[i] = (f32x4){bflo(a[i].x), bfhi(a[i].x), bflo(a[i].y), bfhi(a[i].y)} * (f32x4){bflo(b[i].x), bfhi(b[i].x), bflo(b[i].y), bfhi(b[i].y)};
#pragma unroll
        for (int i = 0; i < 8; ++i) { const f32x4 z = (w0 * y[i] + w1 * y[i + 1] + w2 * y[i + 2]) * (f32x4){bflo(c[i].x), bfhi(c[i].x), bflo(c[i].y), bfhi(c[i].y)};
            if (FP8_WOUT) *(unsigned*)((unsigned char*)MIX + (size_t)(r0 + i) * MIXW + 1024 + c4) = pk_mix8(z.x, z.y, z.z, z.w);
            else { u32x2 w; w.x = cvt_pk_bf16(z.x, z.y); w.y = cvt_pk_bf16(z.z, z.w);
            *(u32x2*)(MIX + (size_t)(r0 + i) * MIXW + 1024 + c4) = w; } }
    }
}
__device__ __forceinline__ void p_mixers(Frame& F, int layer, int nrows) {
    conv_pass(F, layer, nrows);
    for (int ch = F.vcu; ch < TL / 128; ch += F.G) gated_chunk(F, layer, ch);
    const bool ctxl = nrows > TL, bal = ctxl && F.G == 256;
    const bool cg = ctxl && F.vcu >= 16 && F.vcu < 16 + TC / 128;
    if (cg) gated_chunk(F, layer, TL / 128 + F.vcu - 16);
    if (ATTN_PAIR) {
        int gl[6]; int ng = 0;
        { int j = 0; for (int g = F.vcu; g < TL / 32; g += F.G, ++j) { if (bal && cg && j >= 1) break; if (ng < 6) gl[ng++] = g; } }
        if (bal && F.vcu >= 20 && F.vcu < 32) { const int q = F.vcu - 20; if (ng < 6) gl[ng++] = (16 + q / 3) + F.G * (1 + q % 3); }
        if (ctxl && F.vcu < TC / 32) { if (ng < 6) gl[ng++] = TL / 32 + F.vcu; }
        for (int i = (F.wave >> 2); i < ng; i += 2) { int g = gl[0];
#pragma unroll
            for (int k = 1; k < 6; ++k) g = (i == k) ? gl[k] : g;
            attn_task2(F, layer, g, F.wave & 3); }
    } else {
    { int j = 0; for (int g = F.vcu; g < TL / 32; g += F.G, ++j) { if (bal && cg && j >= 1) break; attn_task(F, layer, g, F.wave); } }
    if (bal && F.vcu >= 20 && F.vcu < 32) { const int q = F.vcu - 20; attn_task(F, layer, (16 + q / 3) + F.G * (1 + q % 3), F.wave); }
    if (ctxl && F.vcu < TC / 32) attn_task(F, layer, TL / 32 + F.vcu, F.wave);
    }
}

__device__ __forceinline__ void p_router_fold(Frame& F) {
    const float* mod = (const float*)(F.ws + WS_MOD);
    float* rwp = (float*)(F.ws + WS_RWP); float* bp = (float*)(F.ws + WS_BIASP);
    for (int i = F.vcu * 512 + F.tid; i < DEPTH * 3 * D * NE; i += F.G * 512) {
        const int lm = i / (D * NE), rem = i - lm * (D * NE), k = rem >> 5, e = rem & 31, l = lm / 3;
        const float a = F.ka->in[I_N2G][l * D + k] * (1.0f + mod[(size_t)lm * 6144 + 4 * D + k]);
        rwp[(size_t)lm * (D * NE) + ((k >> 2) * 32 + e) * 4 + (k & 3)] = a * F.ka->in[I_RW][(size_t)l * D * NE + k * NE + e];
    }
    const int gw = F.vcu * 8 + F.wave;
    if (gw < DEPTH * 3 * NE) { const int lm = gw >> 5, e = gw & 31, l = lm / 3; float s = 0.f;
        for (int j = 0; j < 16; ++j) { const int k = F.lane + 64 * j; s += mod[(size_t)lm * 6144 + 3 * D + k] * F.ka->in[I_RW][(size_t)l * D * NE + k * NE + e]; }
        s = wave_sum(s);
        if (F.lane == 0) bp[gw] = s + F.ka->in[I_RB][l * NE + e]; }
}
constexpr int RT_LT = 0;
constexpr int RT_RS = RT_LT + 8 * 32 * 33 * 4;
constexpr int RT_LST = RT_RS + 8 * 32 * 4;
constexpr int RT_HIST = RT_LST + 1024 * 12;
template <bool XBF> __device__ __forceinline__ void p_router_t(Frame& F, int layer, int nrows) {
    LAS float* lt = (LAS float*)(F.lds + RT_LT) + F.wave * (32 * 33); LAS float* rs = (LAS float*)(F.lds + RT_RS) + F.wave * 32;
    LAS int* lst_a = (LAS int*)(F.lds + RT_LST); LAS int* lst_e = lst_a + 1024; LAS float* lst_g = (LAS float*)(lst_e + 1024);
    LAS int* hist = (LAS int*)(F.lds + RT_HIST); LAS int* base = hist + 32; LAS int* nlist = base + 32;
    if (F.tid < 32) hist[F.tid] = 0;
    if (F.tid == 32) nlist[0] = 0;
    __syncthreads();
    const float* XL = (const float*)(F.ws + WS_XL); bf16_t* H = (bf16_t*)(F.ws + WS_H);
    const float* mod = (const float*)(F.ws + WS_MOD) + (size_t)layer * 3 * 6144;
    const int lane = F.lane, r32 = lane & 31, hi = lane >> 5;
    const int ntile = nrows / 32;
    for (int t = F.vcu + F.G * (F.wave & 3); t < ntile; t += 4 * F.G) {
        const int row0 = 32 * t, mi = mod_index(row0);
        if (F.wave >= 4) {
            f32x4 av[4], sv[4];
#pragma unroll
            for (int j = 0; j < 4; ++j) { const int c = 4 * lane + 256 * j;
                av[j] = *(const f32x4*)(F.ka->in[I_N2G] + layer * D + c) * (*(const f32x4*)(mod + (size_t)mi * 6144 + 4 * D + c) + 1.0f); sv[j] = *(const f32x4*)(mod + (size_t)mi * 6144 + 3 * D + c); }
            for (int r4 = 0; r4 < 32; r4 += 4) {
                f32x4 xq[4][4]; u32x2 dq[4][4];
#pragma unroll
                for (int q = 0; q < 4; ++q) { const unsigned char* x = xrow_b(F, layer, row0 + r4 + q); const bf16_t* dx = (const bf16_t*)(F.ws + WS_DX) + (size_t)(row0 + r4 + q) * D;
#pragma unroll
                    for (int j = 0; j < 4; ++j) { const int c = 4 * lane + 256 * j; xq[q][j] = ldx4<XBF>(x, c); dq[q][j] = *(const u32x2*)(dx + c); } }
#pragma unroll
                for (int q = 0; q < 4; ++q) { float s = 0.f;
#pragma unroll
                    for (int j = 0; j < 4; ++j) { xq[q][j] += (f32x4){bflo(dq[q][j].x), bfhi(dq[q][j].x), bflo(dq[q][j].y), bfhi(dq[q][j].y)};
                        s += (xq[q][j].x * xq[q][j].x + xq[q][j].y * xq[q][j].y) + (xq[q][j].z * xq[q][j].z + xq[q][j].w * xq[q][j].w); }
                    s = wave_sum(s);
                    const float rq = 1.0f / sqrtf(s * (1.f / D) + EPS);
                    bf16_t* hrow = H + (size_t)(row0 + r4 + q) * D;
#pragma unroll
                    for (int j = 0; j < 4; ++j) { const int c = 4 * lane + 256 * j; const f32x4 y = (xq[q][j] * rq) * av[j] + sv[j];
                        if constexpr (FP8_MOE1) *(unsigned*)((unsigned char*)(F.ws + WS_H8) + (size_t)(row0 + r4 + q) * D + c) = pk_fp8x4(y.x, y.y, y.z, y.w);
                        else { u32x2 w; w.x = cvt_pk_bf16(y.x, y.y); w.y = cvt_pk_bf16(y.z, y.w); *(u32x2*)(hrow + c) = w; } } }
            }
            continue;
        }
        const unsigned char* xr = xrow_b(F, layer, row0 + r32); const bf16_t* dxr = (const bf16_t*)(F.ws + WS_DX) + (size_t)(row0 + r32) * D + 4 * hi;
        const float* wp = (const float*)(F.ws + WS_RWP) + (size_t)(layer * 3 + mi) * (D * NE) + (hi * 32 + r32) * 4;
        f32x16 acc;
#pragma unroll
        for (int g = 0; g < 16; ++g) acc[g] = 0.f;
        float ss = 0.f;
        f32x4 xa[4], wa[4], xb[4], wb[4]; u32x2 da[4], db[4];
#define RT_LOAD(X, Dv, W, j0) do { _Pragma("unroll") for (int q = 0; q < 4; ++q) { X[q] = ldx4<XBF>(xr, 4 * hi + 8 * ((j0) + q)); Dv[q] = *(const u32x2*)(dxr + 8 * ((j0) + q)); W[q] = *(const f32x4*)(wp + ((j0) + q) * 256); } } while (0)
#define RT_MMA(X, Dv, W) do { _Pragma("unroll") for (int q = 0; q < 4; ++q) { const f32x4 xv = X[q] + (f32x4){bflo(Dv[q].x), bfhi(Dv[q].x), bflo(Dv[q].y), bfhi(Dv[q].y)}; \
            ss += (xv.x * xv.x + xv.y * xv.y) + (xv.z * xv.z + xv.w * xv.w); \
            acc = __builtin_amdgcn_mfma_f32_32x32x2f32(xv.x, W[q].x, acc, 0, 0, 0); acc = __builtin_amdgcn_mfma_f32_32x32x2f32(xv.y, W[q].y, acc, 0, 0, 0); \
            acc = __builtin_amdgcn_mfma_f32_32x32x2f32(xv.z, W[q].z, acc, 0, 0, 0); acc = __builtin_amdgcn_mfma_f32_32x32x2f32(xv.w, W[q].w, acc, 0, 0, 0); } } while (0)
        RT_LOAD(xa, da, wa, 0);
        for (int j = 0; j < 128; j += 8) {
            RT_LOAD(xb, db, wb, j + 4);
            RT_MMA(xa, da, wa);
            if (j + 8 < 128) RT_LOAD(xa, da, wa, j + 8);
            RT_MMA(xb, db, wb);
        }
#undef RT_LOAD
#undef RT_MMA
        ss += __shfl_xor(ss, 32);
        const float rstd = 1.0f / sqrtf(ss * (1.f / D) + EPS);
        if (hi == 0) rs[r32] = rstd;
        LDS_WAIT();
        const float bpe = ((const float*)(F.ws + WS_BIASP))[(layer * 3 + mi) * NE + r32];
#pragma unroll
        for (int g = 0; g < 16; ++g) { const int rr = crow(g, hi); lt[rr * 33 + r32] = acc[g] * rs[rr] + bpe; }
        LDS_WAIT();
        if (lane < 32) {
            float lg[32];
#pragma unroll
            for (int e = 0; e < 32; ++e) lg[e] = lt[lane * 33 + e];
            int te[4]; float tv[4];
#pragma unroll
            for (int k = 0; k < 4; ++k) { float best = lg[0]; int bi = 0;
#pragma unroll
                for (int e = 1; e < 32; ++e) { const bool tk = lg[e] > best; best = tk ? lg[e] : best; bi = tk ? e : bi; }
                te[k] = bi; tv[k] = best;
#pragma unroll
                for (int e = 0; e < 32; ++e) lg[e] = (e == bi) ? -3.0e38f : lg[e]; }
            const float e1 = __expf(tv[1] - tv[0]), e2 = __expf(tv[2] - tv[0]), e3 = __expf(tv[3] - tv[0]); const float inv = 1.0f / (1.0f + e1 + e2 + e3);
            const float gt[4] = {inv, e1 * inv, e2 * inv, e3 * inv};
            const int li = __hip_atomic_fetch_add(nlist, 4, __ATOMIC_RELAXED, __HIP_MEMORY_SCOPE_WORKGROUP);
#pragma unroll
            for (int k = 0; k < 4; ++k) { const int rk = __hip_atomic_fetch_add(hist + te[k], 1, __ATOMIC_RELAXED, __HIP_MEMORY_SCOPE_WORKGROUP);
                lst_a[li + k] = (row0 + lane) * 4 + k; lst_e[li + k] = te[k] | (rk << 8); lst_g[li + k] = gt[k]; }
        }
    }
    p_convert_w1_t<true>(F, layer);
    __syncthreads();
    unsigned* cnt = F.ctl + CW_CNT + layer * NE * 16;
    if (F.tid < 32) base[F.tid] = (int)__hip_atomic_fetch_add(cnt + F.tid * 16, (unsigned)hist[F.tid], __ATOMIC_RELAXED, __HIP_MEMORY_SCOPE_AGENT);
    __syncthreads();
    int* slot_tok = (int*)(F.ws + WS_SLOT_TOK); int* slot_asg = (int*)(F.ws + WS_SLOT_ASG); float* slot_gate = (float*)(F.ws + WS_SLOT_GATE);
    const int nl = nlist[0];
    for (int i = F.tid; i < nl; i += 512) { const int asg = lst_a[i], ee = lst_e[i]; const int e = ee & 255; const int pos = base[e] + (ee >> 8);
        slot_tok[(size_t)e * CAP + pos] = asg >> 2; slot_asg[(size_t)e * CAP + pos] = asg; slot_gate[(size_t)e * CAP + pos] = lst_g[i]; }
    __syncthreads();
}

__device__ __forceinline__ int moe_tables(Frame& F, int layer) {
    LAS int* tstart = (LAS int*)(F.lds + TAB_OFF); LAS int* lcnt = (LAS int*)(F.lds + TAB_LCNT); LAS int* tinfo = (LAS int*)(F.lds + TAB_TINFO);
    unsigned* cnt = F.ctl + CW_CNT + layer * NE * 16;
    if (F.tid < 64) {
        int n = 0; if (F.tid < NE) n = (int)__hip_atomic_load(cnt + F.tid * 16, __ATOMIC_RELAXED, __HIP_MEMORY_SCOPE_AGENT);
        const int c = (n + 255) >> 8; int sfx = c;
#pragma unroll
        for (int o = 1; o < 32; o <<= 1) { const int v = __shfl_up(sfx, o); if (F.tid >= o) sfx += v; }
        if (F.tid < NE) { lcnt[F.tid] = n; tstart[F.tid] = sfx - c; if (F.tid == NE - 1) tstart[NE] = sfx; }
    }
    __syncthreads();
    const int nt = tstart[NE];
    for (int T = F.tid; T < nt; T += 512) { int e = 0;
#pragma unroll
        for (int st = 16; st >= 1; st >>= 1) e += (T >= tstart[e + st]) ? st : 0;
        tinfo[T] = e | ((T - tstart[e]) << 8); }
    __syncthreads();
    return __builtin_amdgcn_readfirstlane(nt);
}

__device__ __forceinline__ void p_router(Frame& F, int layer, int nrows) { if (XL_BF16 && layer > 0) p_router_t<true>(F, layer, nrows); else p_router_t<false>(F, layer, nrows); }
template <bool XBF> __device__ __forceinline__ void p_combine_t(Frame& F, int layer, int nrows) {
    const int gw = F.vcu * 8 + F.wave, NGW = F.G * 8; const int lane = F.lane;
    const float* mod = (const float*)(F.ws + WS_MOD);
    float* XL = (float*)(F.ws + WS_XL); const unsigned char* Y = (const unsigned char*)(F.ws + WS_Y); bf16_t* H = (bf16_t*)(F.ws + WS_H);
    const bool last = layer == DEPTH - 1;
    f32x4 fgv[4];
#pragma unroll
    for (int j = 0; j < 4; ++j) fgv[j] = *(const f32x4*)(F.ka->in[I_FG] + 4 * lane + 256 * j);
    f32x4 g2v[4], ngg[4], nsh[4], nsc[4]; int cur_mi = -1;
    if (!last) {
#pragma unroll
        for (int j = 0; j < 4; ++j) ngg[j] = *(const f32x4*)(F.ka->in[I_N1G] + (layer + 1) * D + 4 * lane + 256 * j); }
    for (int r = gw; r < nrows; r += NGW) {
        const int mi = mod_index(r);
        if (mi != cur_mi) { cur_mi = mi; const float* g2 = mod + (size_t)(layer * 3 + mi) * 6144 + 5 * D; const float* m1 = mod + (size_t)((layer + 1) * 3 + mi) * 6144;
#pragma unroll
            for (int j = 0; j < 4; ++j) { const int c = 4 * lane + 256 * j; g2v[j] = *(const f32x4*)(g2 + c); if (!last) { nsh[j] = *(const f32x4*)(m1 + c); nsc[j] = *(const f32x4*)(m1 + D + c); } } }
        const unsigned char* xb = xrow_b(F, layer, r);
        unsigned yw[4][4]; u32x2 dv[4]; f32x4 xf[4]; u32x2 xh[4];
#pragma unroll
        for (int j = 0; j < 4; ++j) { const int c = 4 * lane + 256 * j;
#pragma unroll
            for (int k = 0; k < 4; ++k) yw[j][k] = *(const unsigned*)(Y + (size_t)(r * 4 + k) * D + c);
            dv[j] = *(const u32x2*)((const bf16_t*)(F.ws + WS_DX) + (size_t)r * D + c);
            if constexpr (XBF) xh[j] = *(const u32x2*)(xb + (size_t)c * 2); else xf[j] = *(const f32x4*)(xb + (size_t)c * 4);
            }
        f32x4 v[4];
#pragma unroll
        for (int j = 0; j < 4; ++j) { f32x4 s = (f32x4){0.f, 0.f, 0.f, 0.f};
#pragma unroll
            for (int k = 0; k < 4; ++k) { const f32x2 lo = __builtin_amdgcn_cvt_pk_f32_fp8((int)yw[j][k], false), hi = __builtin_amdgcn_cvt_pk_f32_fp8((int)yw[j][k], true); s += (f32x4){lo.x, lo.y, hi.x, hi.y}; }
            f32x4 xv; if constexpr (XBF) xv = (f32x4){bflo(xh[j].x), bfhi(xh[j].x), bflo(xh[j].y), bfhi(xh[j].y)}; else xv = xf[j];
            v[j] = xv + (f32x4){bflo(dv[j].x), bfhi(dv[j].x), bflo(dv[j].y), bfhi(dv[j].y)} + g2v[j] * (s * (1.0f / Y8_SCALE)); }
        if (!last) {
#pragma unroll
            for (int j = 0; j < 4; ++j) { if (XL_BF16) { u32x2 w; w.x = cvt_pk_bf16(v[j].x, v[j].y); w.y = cvt_pk_bf16(v[j].z, v[j].w); *(u32x2*)((bf16_t*)XL + (size_t)r * D + 4 * lane + 256 * j) = w; }
                else *(f32x4*)(XL + (size_t)r * D + 4 * lane + 256 * j) = v[j]; }
            norm_mod_store_pre(v, ngg, nsh, nsc, H + (size_t)r * D, lane);
        } else {
            float ss = 0.f;
#pragma unroll
            for (int j = 0; j < 4; ++j) ss += (v[j].x * v[j].x + v[j].y * v[j].y) + (v[j].z * v[j].z + v[j].w * v[j].w);
            const float rstd = 1.0f / sqrtf(wave_sum(ss) * (1.f / D) + EPS);
#pragma unroll
            for (int j = 0; j < 4; ++j) { const int c = 4 * lane + 256 * j; *(f32x4*)(F.out + (size_t)r * D + c) = v[j] * rstd * fgv[j]; }
        }
    }
}
__device__ __forceinline__ void p_combine(Frame& F, int layer, int nrows) { if (XL_BF16 && layer > 0) p_combine_t<true>(F, layer, nrows); else p_combine_t<false>(F, layer, nrows); }

__global__ void __launch_bounds__(512, 2) fwd_kernel(Args args) {
    extern __shared__ __attribute__((aligned(16))) unsigned char lds[];
    Frame F;
#define FRESH() do { int t_ = threadIdx.x; asm volatile("" : "+v"(t_)); F.tid = t_; F.lane = t_ & 63; F.wave = __builtin_amdgcn_readfirstlane(t_ >> 6); \
        int g_ = gridDim.x, b_ = blockIdx.x; asm volatile("" : "+s"(g_), "+s"(b_)); F.G = g_; F.bx = b_; F.vcu = (g_ % 8 == 0) ? (b_ % 8) * (g_ / 8) + b_ / 8 : b_; \
        const __attribute__((address_space(4))) Args* k_ = (const __attribute__((address_space(4))) Args*)__builtin_amdgcn_kernarg_segment_ptr(); asm volatile("" : "+s"(k_)); F.ka = k_; \
        unsigned char* w_ = k_->ws; F.ws = w_; F.ctl = (unsigned*)(w_ + WS_CTL); F.out = k_->out; \
        F.lds = (LAS unsigned char*)lds; F.MISC = (volatile LAS unsigned*)(F.lds + MISC_OFF); } while (0)
    FRESH();
    for (int u = F.tid; u < 128; u += 512) ((LAS unsigned*)(F.lds + MISC_OFF))[u] = 0u;
    __syncthreads();
    const int lo = F.ka->ph_lo, hi = F.ka->ph_hi;
    const bool one_launch = (hi - lo) > 1;
    if (one_launch) (void)xcd_barrier_post(F.ctl + CW_BAR, F.MISC + 8);
#define IN(k) (lo <= (k) && (k) < hi)
#define PH(k) if (IN(k) && ({ FRESH(); true; }))
#define BARRIER_NOW() do { const __attribute__((address_space(4))) Args* kb_ = (const __attribute__((address_space(4))) Args*)__builtin_amdgcn_kernarg_segment_ptr(); asm volatile("" : "+s"(kb_)); \
        XcdBarrier b_; b_.bar = (unsigned*)(kb_->ws + WS_CTL) + CW_BAR; b_.x = xb_xcc_id(); b_.st = (volatile LAS unsigned*)((LAS unsigned char*)lds + MISC_OFF) + 8; xcd_barrier(b_); } while (0)
#define SEAM(k) do { if (IN(k) && IN((k) + 1)) BARRIER_NOW(); } while (0)

#define NREP(t) (((REPEAT_MASK >> (t)) & 1) ? 2 : 1)
#define REP_BEGIN(t) for (int rep_ = 0; rep_ < NREP(t); ++rep_) {
#define REP_END(t) if (rep_ + 1 < NREP(t)) BARRIER_NOW(); }
    PH(0) { REP_BEGIN(0) p0_prologue(F); REP_END(0) } SEAM(0);
    PH(1) { REP_BEGIN(1) p_router_fold(F); p_norm1_first(F); REP_END(1) } SEAM(1);
    for (int l = 0; l < DEPTH; ++l) {
        const int pb = 2 + 7 * l;
        const bool lastl = (l == DEPTH - 1);
        const int nrows = lastl ? TL : MT;
        PH(pb + 0) {
            REP_BEGIN(2)
            pg8::DenseSched<2> Sd; Sd.init(MT, INC, D, F.G, F.bx);
            pg8::EpiWin E{(bf16_t*)(F.ws + WS_P), (bf16_t*)(F.ws + WS_KF), (bf16_t*)(F.ws + WS_VF), (const float*)(F.ws + WS_ROPE), (const float*)(F.ws + WS_ROPE) + 320 * 16};
            pg8::gemm_phase<pg8::EpiWin, pg8::DenseSched<2>, true, 1>(F.lds, (const bf16_t*)(F.ws + WS_H), (const bf16_t*)(F.ws + WS_WIN) + (size_t)l * INC * D, D, Sd, E);
            REP_END(2)
        }
        SEAM(pb + 0);
        PH(pb + 1) {
            REP_BEGIN(3)
            p_mixers(F, l, nrows);
            REP_END(3)
        }
        SEAM(pb + 1);
        PH(pb + 2) {
            pg8::EpiWout E{(bf16_t*)(F.ws + WS_DX), (const float*)(F.ws + WS_MOD) + (size_t)l * 3 * 6144 + 2 * D};
            if constexpr (FP8_WOUT != 0) { pg8::DenseSched<1> Sd; Sd.init(nrows, D, MIXW, F.G, F.bx);
                pg8::gemm_phase<pg8::EpiWout, pg8::DenseSched<1>, true, 1, 1, true, false>(F.lds, F.ws + WS_MIX, F.ws + WS_WOUT + (size_t)l * D * MIXW, MIXW, Sd, E); }
            else { pg8::DenseSched<2> Sd; Sd.init(nrows, D, MIXW, F.G, F.bx);
                pg8::gemm_phase<pg8::EpiWout, pg8::DenseSched<2>, true, 1>(F.lds, (const bf16_t*)(F.ws + WS_MIX), (const bf16_t*)(F.ws + WS_WOUT) + (size_t)l * D * MIXW, MIXW, Sd, E); }
        }
        SEAM(pb + 2);
        PH(pb + 3) { p_router(F, l, nrows); p_convert_w1(F, l); }
        SEAM(pb + 3);
        PH(pb + 4) {
            REP_BEGIN(6)
            const int ntiles = moe_tables(F, l);
            constexpr int EB1 = FP8_MOE1 ? 1 : 2;
            pg8::MoeSched<true, EB1> Sm{(const LAS int*)(F.lds + TAB_TINFO), (const LAS int*)(F.lds + TAB_LCNT), (const int*)(F.ws + WS_SLOT_TOK), FF2 / 256, D * EB1, ntiles * (FF2 / 256), F.G, F.vcu, (unsigned)(FF2 * D * EB1)};
            pg8::EpiMoe1 E{(bf16_t*)(F.ws + WS_ACT), F.ka->in[I_B1] + (size_t)l * NE * FF2};
            pg8::gemm_phase<pg8::EpiMoe1, pg8::MoeSched<true, EB1>, true, (FP8_MOE1 ? SP2_FP8 : 1), EB1, (FP8_MOE1 != 0), false>(F.lds, F.ws + (FP8_MOE1 ? WS_H8 : WS_H), F.ws + WS_W1 + (size_t)l * NE * FF2 * D * EB1, D, Sm, E);
            p_convert_w2(F, l);
            REP_END(6)
        }
        SEAM(pb + 4);
        PH(pb + 5) {
            REP_BEGIN(7)
            const int ntiles = moe_tables(F, l);
            constexpr int EB2 = FP8_MOE2 ? 1 : 2;
            pg8::MoeSched<false, EB2, (FP8_MOE2 != 0)> Sm{(const LAS int*)(F.lds + TAB_TINFO), (const LAS int*)(F.lds + TAB_LCNT), nullptr, D / 256, FF * EB2, ntiles * (D / 256), F.G, F.vcu, (unsigned)(D * FF * EB2)};
            pg8::EpiMoe2 E{(bf16_t*)(F.ws + WS_Y), F.ka->in[I_B2] + (size_t)l * NE * D, (const int*)(F.ws + WS_SLOT_ASG), (const float*)(F.ws + WS_SLOT_GATE), (const LAS int*)(F.lds + TAB_LCNT)};
            pg8::gemm_phase<pg8::EpiMoe2, pg8::MoeSched<false, EB2, (FP8_MOE2 != 0)>, true, (FP8_MOE2 ? SP2_FP8 : 1), EB2, (FP8_MOE2 != 0), (FP8_MOE2 != 0)>(F.lds, F.ws + WS_ACT, F.ws + WS_W2 + (size_t)l * NE * D * FF * EB2, FF, Sm, E);
            REP_END(7)
        }
        SEAM(pb + 5);
        PH(pb + 6) { p_combine(F, l, nrows); }
        if (!lastl) SEAM(pb + 6);
    }
#undef IN
#undef SEAM
}

extern "C" void kernel_launch(void* const* d_in, const int* in_sizes, int n_in, void* d_out, int out_size, void* d_ws, size_t ws_size, hipStream_t stream) {
    static int grid = 0;
    if (grid == 0) {
        if (n_in != 25 || out_size != TL * D || ws_size < WS_END) { fprintf(stderr, "kernel_launch: unexpected problem (n_in %d, out %d, ws %zu)\n", n_in, out_size, ws_size); grid = -1; return; }
        int dev = 0, cus = 0, per_cu = 0;
        if (hipGetDevice(&dev) != hipSuccess || hipDeviceGetAttribute(&cus, hipDeviceAttributeMultiprocessorCount, dev) != hipSuccess) { grid = -1; return; }
        if (hipFuncSetAttribute((const void*)fwd_kernel, hipFuncAttributeMaxDynamicSharedMemorySize, LDS_BYTES) != hipSuccess) { fprintf(stderr, "kernel_launch: hipFuncSetAttribute failed\n"); grid = -1; return; }
        if (hipOccupancyMaxActiveBlocksPerMultiprocessor(&per_cu, (const void*)fwd_kernel, 512, LDS_BYTES) != hipSuccess || per_cu < 1) fprintf(stderr, "kernel_launch: occupancy query reports %d\n", per_cu);
        (void)hipGetLastError();
        grid = cus;
    }
    if (grid < 0) return;
    if (hipMemsetAsync((char*)d_ws + WS_CTL, 0, CTL_ZERO_BYTES, stream) != hipSuccess) return;
    Args a{};
    for (int i = 0; i < 25; ++i) a.in[i] = (const float*)d_in[i];
    a.out = (float*)d_out; a.ws = (unsigned char*)d_ws;
    constexpr int NL = MK_N_LAUNCHES;
    static_assert(NL == 1 || NL == NPHASES, "MK_N_LAUNCHES: 1 or one per phase");
    for (int li = 0; li < NL; ++li) {
        a.ph_lo = (NL == 1) ? 0 : li; a.ph_hi = (NL == 1) ? NPHASES : li + 1;
        hipLaunchKernelGGL(fwd_kernel, dim3(grid), dim3(512), LDS_BYTES, stream, a);
        if (hipPeekAtLastError() != hipSuccess) { fprintf(stderr, "kernel_launch: launch %d failed\n", li); break; }
    }
}
```
